# Optimizing an MI355X kernel written in HIP

```python
import jax, jax.numpy as jnp
from jax import lax
import numpy as np


D_MODEL = 1024
BATCH = 32
SEQ = 2048
DEPTH = 1
DEC_BATCH = 8
DEC_SEQ = 32
PAST_LEN = 2048

CHUNK = 64
N_LEFT_CHUNKS = 8
LEFT_WINDOW = N_LEFT_CHUNKS * CHUNK
BAND = LEFT_WINDOW + CHUNK
HEAD_DIM = 64
D_MIX = D_MODEL
D_A = D_MIX // 2
D_B = D_MIX - D_A
H_A = D_A // HEAD_DIM
H_B = D_B // HEAD_DIM
MAX_REL = 128
N_REL = 2 * MAX_REL + 1
Q_BLOCK = 128
RMS_EPS = 1e-6
MASK_VALUE = -1e30
IN_SIZES = [D_A, D_A, D_A, D_A, D_B, D_B, D_B, D_B, H_B]
D_IN = sum(IN_SIZES)
IN_SPLITS = [int(s) for s in np.cumsum(IN_SIZES)[:-1]]

kernel_name = "hymba_chunk_band_fox_stream_step"


def rmsnorm(x, g):
    xf = x.astype(jnp.float32)
    y = xf * lax.rsqrt(jnp.mean(xf * xf, axis=-1, keepdims=True) + RMS_EPS)
    return (y * g.astype(jnp.float32)).astype(x.dtype)


def project(h, w_in, b_f):
    B, S, _ = h.shape
    z = jnp.einsum('bsd,de->bse', h, w_in)
    qa, ka, va, ga, qb, kb, vb, gb, zf = jnp.split(z, IN_SPLITS, axis=-1)
    heads_a = lambda t: t.reshape(B, S, H_A, HEAD_DIM)
    heads_b = lambda t: t.reshape(B, S, H_B, HEAD_DIM)
    logf = jax.nn.log_sigmoid(zf.astype(jnp.float32) + b_f.astype(jnp.float32))
    return heads_a(qa), heads_a(ka), heads_a(va), ga, heads_b(qb), heads_b(kb), heads_b(vb), gb, logf


def rel_bias_lookup(rel_bias, rel):
    idx = jnp.clip(rel, -MAX_REL, MAX_REL) + MAX_REL
    return rel_bias[:, idx].astype(jnp.float32)


def band_attend(q, k, v, bias, valid):
    s = jnp.einsum('bqhd,bkhd->bhqk', q, k).astype(jnp.float32) * (HEAD_DIM ** -0.5) + bias[None]
    s = jnp.where(valid[None, None], s, MASK_VALUE)
    p = jax.nn.softmax(s, axis=-1)
    return jnp.einsum('bhqk,bkhd->bqhd', p.astype(v.dtype), v)


def forget_attend(q, k, v, cq, ck, valid):
    s = jnp.einsum('bqhd,bkhd->bhqk', q, k).astype(jnp.float32) * (HEAD_DIM ** -0.5)
    s = s + jnp.transpose(cq, (0, 2, 1))[..., :, None] - jnp.transpose(ck, (0, 2, 1))[..., None, :]
    s = jnp.where(valid[None, None], s, MASK_VALUE)
    p = jax.nn.softmax(s, axis=-1)
    return jnp.einsum('bhqk,bkhd->bqhd', p.astype(v.dtype), v)


def chunk_attn_prompt(q, k, v, rel_bias):
    B, S, H, D = q.shape
    nc = S // CHUNK
    pad = ((0, 0), (LEFT_WINDOW, 0), (0, 0), (0, 0))
    kp = jnp.pad(k, pad)
    vp = jnp.pad(v, pad)
    qc = jnp.swapaxes(q.reshape(B, nc, CHUNK, H, D), 0, 1)
    i = jnp.arange(CHUNK)[:, None]
    j = jnp.arange(BAND)[None, :]
    bias = rel_bias_lookup(rel_bias, i + LEFT_WINDOW - j)

    def one_chunk(args):
        n, qn = args
        kn = lax.dynamic_slice_in_dim(kp, n * CHUNK, BAND, axis=1)
        vn = lax.dynamic_slice_in_dim(vp, n * CHUNK, BAND, axis=1)
        valid = (n * CHUNK - LEFT_WINDOW + j) >= 0
        return band_attend(qn, kn, vn, bias, valid)

    out = lax.map(one_chunk, (jnp.arange(nc), qc))
    return jnp.swapaxes(out, 0, 1).reshape(B, S, H, D)


def chunk_attn_sample(q, k, v, cache_k, cache_v, rel_bias):
    T = q.shape[1]
    L = cache_k.shape[1]
    kc = jnp.concatenate([cache_k.astype(k.dtype), k], axis=1)
    vc = jnp.concatenate([cache_v.astype(v.dtype), v], axis=1)
    rel = jnp.arange(T)[:, None] + L - jnp.arange(L + T)[None, :]
    bias = rel_bias_lookup(rel_bias, rel)
    valid = jnp.ones((T, L + T), dtype=bool)
    return band_attend(q, kc, vc, bias, valid)


def forget_attn_prompt(q, k, v, logf):
    B, S, H, D = q.shape
    nb = S // Q_BLOCK
    c = jnp.cumsum(logf, axis=1)
    qb = jnp.swapaxes(q.reshape(B, nb, Q_BLOCK, H, D), 0, 1)
    cb = jnp.swapaxes(c.reshape(B, nb, Q_BLOCK, H), 0, 1)
    kpos = jnp.arange(S)

    def one_block(args):
        n, qn, cn = args
        qpos = n * Q_BLOCK + jnp.arange(Q_BLOCK)
        valid = kpos[None, :] <= qpos[:, None]
        return forget_attend(qn, k, v, cn, c, valid)

    out = lax.map(one_block, (jnp.arange(nb), qb, cb))
    return jnp.swapaxes(out, 0, 1).reshape(B, S, H, D)


def forget_attn_sample(q, k, v, logf, cache_k, cache_v, cache_logf):
    T = q.shape[1]
    P = cache_k.shape[1]
    kc = jnp.concatenate([cache_k.astype(k.dtype), k], axis=1)
    vc = jnp.concatenate([cache_v.astype(v.dtype), v], axis=1)
    c = jnp.cumsum(jnp.concatenate([cache_logf.astype(jnp.float32), logf], axis=1), axis=1)
    cq = c[:, P:]
    valid = jnp.arange(P + T)[None, :] <= (P + jnp.arange(T))[:, None]
    return forget_attend(q, kc, vc, cq, c, valid)


def merge_out(oa, ga, ob, gb, w_out):
    B, S = oa.shape[:2]
    ya = oa.reshape(B, S, D_A) * jax.nn.silu(ga)
    yb = ob.reshape(B, S, D_B) * jax.nn.silu(gb)
    return jnp.einsum('bse,ed->bsd', jnp.concatenate([ya, yb], axis=-1), w_out)


def setup_inputs(seed: int = 0) -> dict:
    key = jax.random.key(seed)
    ks = jax.random.split(key, 16)
    la = min(LEFT_WINDOW, PAST_LEN)
    f32 = jnp.float32
    return {
        "x_prompt": jax.random.normal(ks[0], (BATCH, SEQ, D_MODEL), f32),
        "x_sample": jax.random.normal(ks[1], (DEC_BATCH, DEC_SEQ, D_MODEL), f32),
        "cache_a_k": jax.random.normal(ks[2], (DEPTH, DEC_BATCH, la, H_A, HEAD_DIM), f32),
        "cache_a_v": jax.random.normal(ks[3], (DEPTH, DEC_BATCH, la, H_A, HEAD_DIM), f32),
        "cache_b_k": jax.random.normal(ks[4], (DEPTH, DEC_BATCH, PAST_LEN, H_B, HEAD_DIM), f32),
        "cache_b_v": jax.random.normal(ks[5], (DEPTH, DEC_BATCH, PAST_LEN, H_B, HEAD_DIM), f32),
        "cache_b_logf": jax.nn.log_sigmoid(1.0 + 0.5 * jax.random.normal(ks[6], (DEPTH, DEC_BATCH, PAST_LEN, H_B), f32)),
        "norm_gain": 1.0 + 0.01 * jax.random.normal(ks[7], (DEPTH, D_MODEL), f32),
        "w_in": jax.random.normal(ks[8], (DEPTH, D_MODEL, D_IN), f32) * D_MODEL ** -0.5,
        "b_forget": 1.0 + 0.1 * jax.random.normal(ks[9], (DEPTH, H_B), f32),
        "rel_bias": 0.1 * jax.random.normal(ks[10], (DEPTH, H_A, N_REL), f32),
        "w_out": jax.random.normal(ks[11], (DEPTH, D_MIX, D_MODEL), f32) * D_MIX ** -0.5,
        "final_gain": 1.0 + 0.01 * jax.random.normal(ks[12], (D_MODEL,), f32),
    }


def reference(x_prompt, x_sample, cache_a_k, cache_a_v, cache_b_k, cache_b_v, cache_b_logf,
              norm_gain, w_in, b_forget, rel_bias, w_out, final_gain):
    xp = x_prompt
    xs = x_sample
    a_k_p, a_v_p, b_k_p, b_v_p, b_f_p = [], [], [], [], []
    a_k_s, a_v_s, b_k_s, b_v_s, b_f_s = [], [], [], [], []
    keep_a = min(LEFT_WINDOW, xp.shape[1])
    for l in range(DEPTH):
        hp = rmsnorm(xp, norm_gain[l])
        qa, ka, va, ga, qb, kb, vb, gb, logf = project(hp, w_in[l], b_forget[l])
        oa = chunk_attn_prompt(qa, ka, va, rel_bias[l])
        ob = forget_attn_prompt(qb, kb, vb, logf)
        xp = xp + merge_out(oa, ga, ob, gb, w_out[l])
        a_k_p.append(ka[:, -keep_a:])
        a_v_p.append(va[:, -keep_a:])
        b_k_p.append(kb)
        b_v_p.append(vb)
        b_f_p.append(logf)

        hs = rmsnorm(xs, norm_gain[l])
        qa, ka, va, ga, qb, kb, vb, gb, logf = project(hs, w_in[l], b_forget[l])
        oa = chunk_attn_sample(qa, ka, va, cache_a_k[l], cache_a_v[l], rel_bias[l])
        ob = forget_attn_sample(qb, kb, vb, logf, cache_b_k[l], cache_b_v[l], cache_b_logf[l])
        xs = xs + merge_out(oa, ga, ob, gb, w_out[l])
        a_k_s.append(ka)
        a_v_s.append(va)
        b_k_s.append(kb)
        b_v_s.append(vb)
        b_f_s.append(logf)

    y_prompt = rmsnorm(xp, final_gain)
    y_sample = rmsnorm(xs, final_gain)
    return (y_prompt, y_sample,
            jnp.stack(a_k_p), jnp.stack(a_v_p), jnp.stack(b_k_p), jnp.stack(b_v_p), jnp.stack(b_f_p),
            jnp.stack(a_k_s), jnp.stack(a_v_s), jnp.stack(b_k_s), jnp.stack(b_v_s), jnp.stack(b_f_s))
```

```cpp
#include <hip/hip_runtime.h>
#include <hip/hip_cooperative_groups.h>
#include <cstdio>
#include <cstdint>
namespace cg = cooperative_groups;
namespace pg8 {
#define PG8_LAS __attribute__((address_space(3)))
typedef unsigned short bf16_t;
typedef short bf16x8 __attribute__((ext_vector_type(8)));
typedef float f32x4 __attribute__((ext_vector_type(4)));
typedef unsigned u32x4 __attribute__((ext_vector_type(4)));
constexpr int BM = 256, BK = 64, HALF = 128, HTB = HALF * BK * 2  , STAGE_BYTES = 8 * HTB, NXCD = 8, WGM = 8;

__host__ __device__ __forceinline__ int lds_byte(int r, int c) { const int st = (r >> 4) * 2 + (c >> 5), rr = r & 15, cc = c & 31, ob = rr * 64 + cc * 2; return st * 1024 + (ob ^ (((ob >> 9) & 1) << 5)); }
__host__ __device__ __forceinline__ void stage_rc(int b, int& R, int& C) { const int st = b / 1024, sb = b % 1024, swz = sb ^ (((sb >> 9) & 1) << 5); R = (st >> 1) * 16 + swz / 64; C = (st & 1) * 32 + (swz % 64) / 2; }
__host__ __device__ __forceinline__ int perm32(int rho) { const int n = rho >> 4, i = rho & 15; return 8 * (i >> 2) + 4 * n + (i & 3); }

struct Unit { int pm, pn; };
struct Gemm { const bf16_t* A; const bf16_t* Bt; int M, N, K; };

struct StaticOrder {
    int nM, nN, nwg, G, c;
    __host__ __device__ void init(int M, int N, int G_, int c_) { nM = M / BM; nN = N / BM; nwg = nM * nN; G = G_; c = c_; }
    __host__ __device__ bool next(int i, Unit& u) const {
        const long L = (long)i * G + c; if (L >= nwg) return false;
        int wgid = (int)L; { const int q = nwg / NXCD, r = nwg % NXCD, xcd = wgid % NXCD, off = wgid / NXCD; wgid = (xcd < r ? xcd * (q + 1) : r * (q + 1) + (xcd - r) * q) + off; }
        const int nig = WGM * nN, gid = wgid / nig, fm = gid * WGM, gsz = (nM - fm) < WGM ? (nM - fm) : WGM;
        u.pm = fm + ((wgid % nig) % gsz); u.pn = (wgid % nig) / gsz; return true;
    }
    __device__ __forceinline__ void a_ready(const Unit&) const {}
    __device__ __forceinline__ void done(const Unit&) const {}
};
__device__ __forceinline__ unsigned cvt_pk_bf16(float lo, float hi) { unsigned r; asm volatile("v_cvt_pk_bf16_f32 %0, %1, %2" : "=v"(r) : "v"(lo), "v"(hi)); return r; }
typedef float f32x2 __attribute__((ext_vector_type(2)));
template <class Epi, class Sched, bool ALIGN_EPI = false, bool SP2 = false>
__device__ __forceinline__ void gemm_phase(PG8_LAS unsigned char* lds, const Gemm g, const Sched& S, const Epi& E, const int tid) {
    const int wid = __builtin_amdgcn_readfirstlane(tid >> 6), lane = tid & 63, wr = wid >> 2, wc = wid & 3, fr = lane & 15, fq = lane >> 4;
    const int K = g.K, nt = K / BK;
    unsigned voffA[2], voffB[2];
#pragma unroll
    for (int i = 0; i < 2; ++i) { int R, C; stage_rc(tid * 16 + i * 8192, R, C); const int Rb = Epi::PERM ? ((R & ~31) + perm32(R & 31)) : R;
        voffA[i] = (unsigned)(R * K + C) * 2u; voffB[i] = (unsigned)(Rb * K + C) * 2u; }
    const size_t kstep = (size_t)(BK * 2);
    const size_t hstep = (size_t)HALF * K * 2;
    const size_t tstep = 2 * hstep;
    const unsigned ldsw = (unsigned)wid * 1024u;
    const int aoff = lds_byte(wr * 64 + fr, fq * 8), boff = lds_byte(wc * 32 + fr, fq * 8);
#define PG8_SA(b, h) (((b) * 2 + (h)) * HTB)
#define PG8_SB(b, h) ((4 + (b) * 2 + (h)) * HTB)
#define PG8_STAGE(bufoff, gbase, voff) do { _Pragma("unroll") for (int _i = 0; _i < 2; ++_i) \
        __builtin_amdgcn_global_load_lds((const unsigned*)((const char*)(gbase) + (voff)[_i]), (PG8_LAS unsigned*)(lds + (bufoff) + ldsw + _i * 8192), 16, 0, 0); } while (0)
#define PG8_LDA(dst, b, h) do { _Pragma("unroll") for (int m = 0; m < 4; ++m) _Pragma("unroll") for (int k = 0; k < 2; ++k) dst[m][k] = *(const PG8_LAS bf16x8*)(lds + PG8_SA(b, h) + aoff + m * 2048 + k * 1024); } while (0)
#define PG8_LDB(dst, b, h) do { _Pragma("unroll") for (int n = 0; n < 2; ++n) _Pragma("unroll") for (int k = 0; k < 2; ++k) dst[n][k] = *(const PG8_LAS bf16x8*)(lds + PG8_SB(b, h) + boff + n * 2048 + k * 1024); } while (0)
#define PG8_MMA(ai, bj, At, Bt) do { __builtin_amdgcn_s_setprio(1); _Pragma("unroll") for (int m = 0; m < 4; ++m) _Pragma("unroll") for (int n = 0; n < 2; ++n) _Pragma("unroll") for (int k = 0; k < 2; ++k) \
        acc[ai][bj][m][n] = __builtin_amdgcn_mfma_f32_16x16x32_bf16(Bt[n][k], At[m][k], acc[ai][bj][m][n], 0, 0, 0); __builtin_amdgcn_s_setprio(0); } while (0)
#define PG8_WAIT_V(n) asm volatile("s_waitcnt vmcnt(" #n ")" ::: "memory")
#define PG8_WAIT_L(n) asm volatile("s_waitcnt lgkmcnt(" #n ")" ::: "memory")
#define PG8_BAR __builtin_amdgcn_s_barrier()
#define PG8_SCHED __builtin_amdgcn_sched_barrier(0)
    Unit cur, nxt; int ui = 0;
    if (!S.next(0, cur)) return;
    f32x4 acc[2][2][4][2];
#pragma unroll
    for (int a = 0; a < 2; ++a)
#pragma unroll
        for (int b = 0; b < 2; ++b)
#pragma unroll
            for (int m = 0; m < 4; ++m)
#pragma unroll
                for (int n = 0; n < 2; ++n) acc[a][b][m][n] = (f32x4){0.f, 0.f, 0.f, 0.f};
    bf16x8 At[4][2], B0[2][2], B1[2][2];
    const char* cA = (const char*)g.A + (size_t)cur.pm * tstep; const char* cB = (const char*)g.Bt + (size_t)cur.pn * tstep;
    S.a_ready(cur);
    if constexpr (SP2) {
        PG8_STAGE(PG8_SB(0, 0), cB, voffB); PG8_STAGE(PG8_SB(0, 1), cB + hstep, voffB); PG8_STAGE(PG8_SA(0, 0), cA, voffA); PG8_STAGE(PG8_SA(0, 1), cA + hstep, voffA);
        if (wr == 1) PG8_BAR;
        PG8_WAIT_V(2); PG8_BAR;
        PG8_STAGE(PG8_SB(1, 0), cB + kstep, voffB); PG8_STAGE(PG8_SA(1, 0), cA + kstep, voffA); PG8_STAGE(PG8_SB(1, 1), cB + hstep + kstep, voffB);
        PG8_WAIT_V(6); PG8_BAR;
    } else {
        PG8_STAGE(PG8_SB(0, 0), cB, voffB); PG8_STAGE(PG8_SA(0, 0), cA, voffA); PG8_STAGE(PG8_SB(0, 1), cB + hstep, voffB); PG8_STAGE(PG8_SA(0, 1), cA + hstep, voffA);
        if (wr == 1) PG8_BAR;
        PG8_WAIT_V(4); PG8_BAR;
        PG8_STAGE(PG8_SB(1, 0), cB + kstep, voffB); PG8_STAGE(PG8_SA(1, 0), cA + kstep, voffA); PG8_STAGE(PG8_SB(1, 1), cB + hstep + kstep, voffB);
        PG8_WAIT_V(6); PG8_BAR;
    }
    for (;;) {
        const bool has_next = S.next(ui + 1, nxt);
        const char* nA = has_next ? (const char*)g.A + (size_t)nxt.pm * tstep : cA; const char* nB = has_next ? (const char*)g.Bt + (size_t)nxt.pn * tstep : cB;
        for (int t = 0; t < nt; t += 2) {
            const bool last = (t == nt - 2);
            const char* a1 = cA + (size_t)(t + 1) * kstep;
            const char* a2 = last ? nA : cA + (size_t)(t + 2) * kstep; const char* b2 = last ? nB : cB + (size_t)(t + 2) * kstep;
            const char* a3 = a2 + kstep; const char* b3 = b2 + kstep;
            if (last && has_next) S.a_ready(nxt);
            if constexpr (SP2) {
            PG8_LDB(B0, 0, 0); PG8_LDB(B1, 0, 1); PG8_SCHED; PG8_LDA(At, 0, 0); PG8_STAGE(PG8_SA(1, 1), a1 + hstep, voffA);
            PG8_WAIT_V(8); PG8_WAIT_L(0); PG8_BAR; PG8_MMA(0, 0, At, B0); PG8_MMA(0, 1, At, B1); PG8_BAR; PG8_SCHED;
            PG8_LDA(At, 0, 1); PG8_STAGE(PG8_SB(0, 0), b2, voffB); PG8_STAGE(PG8_SB(0, 1), b2 + hstep, voffB); PG8_STAGE(PG8_SA(0, 0), a2, voffA);
            PG8_WAIT_V(8); PG8_WAIT_L(0); PG8_BAR; PG8_MMA(1, 0, At, B0); PG8_MMA(1, 1, At, B1); PG8_BAR; PG8_SCHED;
            PG8_LDB(B0, 1, 0); PG8_LDB(B1, 1, 1); PG8_SCHED; PG8_LDA(At, 1, 0); PG8_STAGE(PG8_SA(0, 1), a2 + hstep, voffA);
            PG8_WAIT_V(8); PG8_WAIT_L(0); PG8_BAR; PG8_MMA(0, 0, At, B0); PG8_MMA(0, 1, At, B1); PG8_BAR; PG8_SCHED;
            PG8_LDA(At, 1, 1); PG8_STAGE(PG8_SB(1, 0), b3, voffB); PG8_STAGE(PG8_SB(1, 1), b3 + hstep, voffB); PG8_STAGE(PG8_SA(1, 0), a3, voffA);
            PG8_WAIT_V(8); PG8_WAIT_L(0); PG8_BAR; PG8_MMA(1, 0, At, B0); PG8_MMA(1, 1, At, B1); PG8_BAR; PG8_SCHED;
            } else {
            PG8_LDB(B0, 0, 0); PG8_SCHED; PG8_LDA(At, 0, 0); PG8_STAGE(PG8_SA(1, 1), a1 + hstep, voffA);
            PG8_WAIT_L(8); PG8_BAR; PG8_WAIT_L(0); PG8_MMA(0, 0, At, B0); PG8_BAR; PG8_SCHED;
            PG8_LDB(B1, 0, 1); PG8_STAGE(PG8_SB(0, 0), b2, voffB);
            PG8_BAR; PG8_WAIT_L(0); PG8_MMA(0, 1, At, B1); PG8_BAR;
            PG8_LDA(At, 0, 1); PG8_STAGE(PG8_SA(0, 0), a2, voffA);
            PG8_BAR; PG8_WAIT_L(0); PG8_MMA(1, 0, At, B0); PG8_BAR; PG8_SCHED;
            PG8_STAGE(PG8_SB(0, 1), b2 + hstep, voffB);
            PG8_WAIT_V(6); PG8_BAR; PG8_MMA(1, 1, At, B1); PG8_BAR;
            PG8_LDB(B0, 1, 0); PG8_SCHED; PG8_LDA(At, 1, 0); PG8_STAGE(PG8_SA(0, 1), a2 + hstep, voffA);
            PG8_WAIT_L(8); PG8_BAR; PG8_WAIT_L(0); PG8_MMA(0, 0, At, B0); PG8_BAR; PG8_SCHED;
            PG8_LDB(B1, 1, 1); PG8_STAGE(PG8_SB(1, 0), b3, voffB);
            PG8_BAR; PG8_WAIT_L(0); PG8_MMA(0, 1, At, B1); PG8_BAR;
            PG8_LDA(At, 1, 1); PG8_STAGE(PG8_SA(1, 0), a3, voffA);
            PG8_BAR; PG8_WAIT_L(0); PG8_MMA(1, 0, At, B0); PG8_BAR; PG8_SCHED;
            PG8_STAGE(PG8_SB(1, 1), b3 + hstep, voffB);
            PG8_WAIT_V(6); PG8_BAR; PG8_MMA(1, 1, At, B1); PG8_BAR;
            }
        }
        if constexpr (ALIGN_EPI) { if (wr == 0) PG8_BAR; }
        if constexpr (!Epi::AFTER_DRAIN) { E(acc, cur, wr, wc, fr, fq); S.done(cur); }
        if (!has_next) break;
#pragma unroll
        for (int a = 0; a < 2; ++a)
#pragma unroll
            for (int b = 0; b < 2; ++b)
#pragma unroll
                for (int m = 0; m < 4; ++m)
#pragma unroll
                    for (int n = 0; n < 2; ++n) acc[a][b][m][n] = (f32x4){0.f, 0.f, 0.f, 0.f};
        cur = nxt; cA = nA; cB = nB; ++ui;
        if constexpr (ALIGN_EPI) { if (wr == 1) PG8_BAR; }
    }
    PG8_WAIT_V(0);
    if constexpr (!ALIGN_EPI) { if (wr == 0) PG8_BAR; }
    PG8_BAR;
    if constexpr (Epi::AFTER_DRAIN) { E.fused(acc, cur, wr, wc, fr, fq, lds, wid, lane); S.done(cur); }
#undef PG8_SA
#undef PG8_SB
#undef PG8_STAGE
#undef PG8_LDA
#undef PG8_LDB
#undef PG8_MMA
#undef PG8_WAIT_V
#undef PG8_WAIT_L
#undef PG8_BAR
#undef PG8_SCHED
}
}

#define LAS __attribute__((address_space(3)))
typedef unsigned short bf16_t;
typedef short bf16x8 __attribute__((ext_vector_type(8)));
typedef short s16x4 __attribute__((ext_vector_type(4)));
typedef float f32x4 __attribute__((ext_vector_type(4)));
typedef float f32x16 __attribute__((ext_vector_type(16)));
typedef unsigned u32x4 __attribute__((ext_vector_type(4)));
typedef unsigned u32x2 __attribute__((ext_vector_type(2)));

constexpr int DM = 1024, NB = 32, SEQ = 2048, MP = NB * SEQ, NSB = 8, NST = 32, MS = NSB * NST, MT = MP + MS;
constexpr int PAST = 2048, LAC = 512, DIN = 4104, NREL = 257;
constexpr int LAS_LEN = LAC + NST  , LBS_LEN = PAST + NST  ;
constexpr float LOG2E = 1.4426950408889634f, QSCALE = 0.125f * LOG2E, RMS_EPS = 1e-6f;

constexpr size_t O_Y = 0;
constexpr size_t O_AKP = (size_t)MT * 1024;
constexpr size_t O_AVP = O_AKP + (size_t)NB * 512 * 512;
constexpr size_t O_BKP = O_AVP + (size_t)NB * 512 * 512;
constexpr size_t O_BVP = O_BKP + (size_t)MP * 512;
constexpr size_t O_LFP = O_BVP + (size_t)MP * 512;
constexpr size_t O_AKS = O_LFP + (size_t)MP * 8;
constexpr size_t O_AVS = O_AKS + (size_t)MS * 512;
constexpr size_t O_BKS = O_AVS + (size_t)MS * 512;
constexpr size_t O_BVS = O_BKS + (size_t)MS * 512;
constexpr size_t O_LFS = O_BVS + (size_t)MS * 512;
constexpr size_t O_END = O_LFS + (size_t)MS * 8;

constexpr size_t MiB = 1u << 20;
constexpr size_t WS_WIN = 0, WS_WOUT = 8 * MiB, WS_C2P = 10 * MiB, WS_C2S = 12 * MiB, WS_PS = 13 * MiB;
constexpr size_t WS_KAS = 18 * MiB, WS_VAS = 23 * MiB, WS_KBS = 28 * MiB, WS_VBS = 45 * MiB;
constexpr size_t WS_H = 64 * MiB;
constexpr size_t WS_SEG = 200 * MiB, SEG_STRIDE = 65 * MiB;
constexpr size_t WS_END = WS_SEG + 8 * SEG_STRIDE;
static_assert((size_t)MT * 512 * 2 <= SEG_STRIDE && (size_t)MT * 1024 * 2 <= WS_SEG - WS_H && (size_t)MT * 64 <= WS_KAS - WS_PS, "ws map");
static_assert((size_t)NSB * LAS_LEN * 512 * 2 <= 5 * MiB && (size_t)NSB * LBS_LEN * 512 * 2 <= 17 * MiB, "ws map");

constexpr int LDS_BYTES = 147456;

struct Params {
    const float* xp; const float* xs; const float* cak; const float* cav; const float* cbk; const float* cbv; const float* cblf;
    const float* gain; const float* win; const float* bfg; const float* relb; const float* wout; const float* fgain;
    float* out; unsigned char* ws;
};

__device__ __forceinline__ float wave_sum(float v) {
#pragma unroll
    for (int o = 1; o < 64; o <<= 1) v += __shfl_xor(v, o);
    return v;
}
typedef float f32x2_t __attribute__((ext_vector_type(2))); typedef __bf16 bf16x2_t __attribute__((ext_vector_type(2)));
__device__ __forceinline__ unsigned pk2(float lo, float hi) { f32x2_t v = {lo, hi}; bf16x2_t b = __builtin_convertvector(v, bf16x2_t); return __builtin_bit_cast(unsigned, b); }
__device__ __forceinline__ float bf_lo(unsigned w) { return __uint_as_float(w << 16); }
__device__ __forceinline__ float bf_hi(unsigned w) { return __uint_as_float(w & 0xffff0000u); }

struct EpiProj {
    static constexpr bool PERM = true, AFTER_DRAIN = false;
    unsigned char* ws; float* out;
    __device__ __forceinline__ void operator()(const pg8::f32x4 (&acc)[2][2][4][2], const pg8::Unit& u, int wr, int wc, int fr, int fq) const {
        const int seg = u.pn >> 1, kind = seg & 3, grp = seg >> 2;
        const bool smp = (u.pm == MP / 256);
        const bool kv = (kind == 1 || kind == 2);
        const int colw = (u.pn & 1) * 256 + wc * 32 + 8 * fq;
        bf16_t* bbase = (bf16_t*)(ws + WS_SEG + (size_t)seg * SEG_STRIDE);
        int sL = 0, sP = 0;
        if (smp && kv) {
            if (grp == 0) { bbase = (bf16_t*)(ws + (kind == 1 ? WS_KAS : WS_VAS)); sL = LAS_LEN; sP = LAC; }
            else          { bbase = (bf16_t*)(ws + (kind == 1 ? WS_KBS : WS_VBS)); sL = LBS_LEN; sP = PAST; }
        }
        float* fdst = nullptr; size_t frow0 = 0;
        if (kv) {
            if (smp) { fdst = out + (grp == 0 ? (kind == 1 ? O_AKS : O_AVS) : (kind == 1 ? O_BKS : O_BVS)); }
            else if (grp == 1) { fdst = out + (kind == 1 ? O_BKP : O_BVP); frow0 = (size_t)u.pm * 256; }
            else if ((u.pm & 7) >= 6) { fdst = out + (kind == 1 ? O_AKP : O_AVP); frow0 = (size_t)(u.pm >> 3) * 512 + (size_t)((u.pm & 7) - 6) * 256; }
        }
#pragma unroll
        for (int ai = 0; ai < 2; ++ai)
#pragma unroll
            for (int m = 0; m < 4; ++m) {
                const int rt = ai * 128 + wr * 64 + m * 16 + fr;
                const size_t brow = sL ? (size_t)((rt >> 5) * sL + sP + (rt & 31)) : (size_t)u.pm * 256 + rt;
                bf16_t* bp = bbase + brow * 512 + colw;
#pragma unroll
                for (int bj = 0; bj < 2; ++bj) {
                    pg8::f32x4 v0 = acc[ai][bj][m][0], v1 = acc[ai][bj][m][1];
                    if (fdst) { float* fp = fdst + (frow0 + rt) * 512 + colw + bj * 128; *(pg8::f32x4*)fp = v0; *(pg8::f32x4*)(fp + 4) = v1; }
                    if (kind == 0) { v0 = v0 * QSCALE; v1 = v1 * QSCALE; }
                    else if (kind == 3) {
#pragma unroll
                        for (int e = 0; e < 4; ++e) {
                            v0[e] = v0[e] * __builtin_amdgcn_rcpf(1.0f + __builtin_amdgcn_exp2f(-LOG2E * v0[e]));
                            v1[e] = v1[e] * __builtin_amdgcn_rcpf(1.0f + __builtin_amdgcn_exp2f(-LOG2E * v1[e]));
                        }
                    }
                    pg8::u32x4 w; w.x = pk2(v0[0], v0[1]); w.y = pk2(v0[2], v0[3]); w.z = pk2(v1[0], v1[1]); w.w = pk2(v1[2], v1[3]);
                    *(pg8::u32x4*)(bp + bj * 128) = w;
                }
            }
    }
};

struct EpiOut {
    static constexpr bool PERM = false, AFTER_DRAIN = false;
    const float* xp; const float* xs; float* out; float* ps;
    __device__ __forceinline__ void operator()(const pg8::f32x4 (&acc)[2][2][4][2], const pg8::Unit& u, int wr, int wc, int fr, int fq) const {
        const bool smp = (u.pm == MP / 256);
        const float* xb = smp ? xs : xp;
        const int c0 = u.pn * 256 + wc * 32 + 4 * fq;
#pragma unroll
        for (int ai = 0; ai < 2; ++ai)
#pragma unroll
            for (int m = 0; m < 4; ++m) {
                const int rt = ai * 128 + wr * 64 + m * 16 + fr;
                const unsigned grow = (unsigned)u.pm * 256u + (unsigned)rt;
                const float* xrow = xb + (smp ? (unsigned)rt : grow) * 1024u;
                float* orow = out + grow * 1024u;
                float ss = 0.f;
#pragma unroll
                for (int bj = 0; bj < 2; ++bj)
#pragma unroll
                    for (int n = 0; n < 2; ++n) {
                        const int c = c0 + bj * 128 + n * 16;
                        const pg8::f32x4 xv = *(const pg8::f32x4*)(xrow + c);
                        const pg8::f32x4 r = xv + acc[ai][bj][m][n];
                        ss += (r[0] * r[0] + r[1] * r[1]) + (r[2] * r[2] + r[3] * r[3]);
                        *(pg8::f32x4*)(orow + c) = r;
                    }
                ss += __shfl_xor(ss, 16); ss += __shfl_xor(ss, 32);
                if (fq == 0) ps[grow * 16u + (unsigned)(u.pn * 4 + wc)] = ss;
                asm volatile("" ::: "memory");
            }
    }
};

__device__ __forceinline__ void p0_transpose_item(const float* W, int ldw, int ncols, int K, bf16_t* WT, LAS float* scr, int item, int lane) {
    const int nblk = ncols / 32, kb = item / nblk, nb = item % nblk, k0 = 64 * kb, n0 = 32 * nb;
#pragma unroll 8
    for (int i = 0; i < 32; ++i) { const int kk = 2 * i + (lane >> 5); scr[kk * 33 + (lane & 31)] = W[(size_t)(k0 + kk) * ldw + n0 + (lane & 31)]; }
    asm volatile("s_waitcnt lgkmcnt(0)" ::: "memory");
    const int c = lane & 7;
#pragma unroll
    for (int j = 0; j < 4; ++j) { const int n = (lane >> 3) + 8 * j; const LAS float* s = scr + (8 * c) * 33 + n;
        u32x4 o; o.x = pk2(s[0 * 33], s[1 * 33]); o.y = pk2(s[2 * 33], s[3 * 33]); o.z = pk2(s[4 * 33], s[5 * 33]); o.w = pk2(s[6 * 33], s[7 * 33]);
        *(u32x4*)(WT + (size_t)(n0 + n) * K + k0 + 8 * c) = o; }
    asm volatile("s_waitcnt lgkmcnt(0)" ::: "memory");
}

__device__ __forceinline__ void conv_chunk(const float* src, bf16_t* dst, int c, int pshift, int L) {
    const int row = c >> 6, col8 = c & 63, b = row >> pshift, pos = row & ((1 << pshift) - 1);
    const f32x4 a = *(const f32x4*)(src + (size_t)c * 8), d = *(const f32x4*)(src + (size_t)c * 8 + 4);
    u32x4 o; o.x = pk2(a[0], a[1]); o.y = pk2(a[2], a[3]); o.z = pk2(d[0], d[1]); o.w = pk2(d[2], d[3]);
    *(u32x4*)(dst + ((size_t)(b * L + pos) * 512 + col8 * 8)) = o;
}

__device__ __forceinline__ void phase0(const Params& P, LAS unsigned char* lds, int tid, int lane, int wave) {
    const int G = gridDim.x, gw = blockIdx.x * 8 + wave, NGW = G * 8;
    bf16_t* Win_t = (bf16_t*)(P.ws + WS_WIN); bf16_t* Wout_t = (bf16_t*)(P.ws + WS_WOUT); bf16_t* H = (bf16_t*)(P.ws + WS_H);
    LAS float* wfL = (LAS float*)(lds + 69632);
    for (int i = tid; i < 1024 * 8; i += 512) wfL[i] = P.win[(size_t)(i >> 3) * DIN + 4096 + (i & 7)];
    LAS float* scr = (LAS float*)(lds + wave * 8704);
    for (int it = gw; it < 2048 + 512; it += NGW) {
        if (it < 2048) p0_transpose_item(P.win, DIN, 4096, 1024, Win_t, scr, it, lane);
        else p0_transpose_item(P.wout, 1024, 1024, 1024, Wout_t, scr, it - 2048, lane);
    }
    __syncthreads();
    f32x4 g4[4];
#pragma unroll
    for (int j = 0; j < 4; ++j) g4[j] = *(const f32x4*)(P.gain + 4 * lane + 256 * j);
    const float bfv = P.bfg[lane & 7];
    for (int m = gw; m < MT; m += NGW) {
        const float* xrow = (m < MP) ? P.xp + (size_t)m * 1024 : P.xs + (size_t)(m - MP) * 1024;
        f32x4 v[4]; float ss = 0.f;
#pragma unroll
        for (int j = 0; j < 4; ++j) { v[j] = *(const f32x4*)(xrow + 4 * lane + 256 * j); ss += (v[j][0] * v[j][0] + v[j][1] * v[j][1]) + (v[j][2] * v[j][2] + v[j][3] * v[j][3]); }
        ss = wave_sum(ss);
        const float rstd = 1.0f / sqrtf(ss * (1.0f / 1024.0f) + RMS_EPS);
        float z0 = 0.f, z1 = 0.f, z2 = 0.f, z3 = 0.f, z4 = 0.f, z5 = 0.f, z6 = 0.f, z7 = 0.f;
#pragma unroll
        for (int j = 0; j < 4; ++j) {
            const f32x4 hv = v[j] * rstd * g4[j];
            u32x2 w; w.x = pk2(hv[0], hv[1]); w.y = pk2(hv[2], hv[3]);
            *(u32x2*)(H + (size_t)m * 1024 + 4 * lane + 256 * j) = w;
#pragma unroll
            for (int e = 0; e < 4; ++e) {
                const int k = 4 * lane + 256 * j + e;
                const f32x4 w0 = *(const LAS f32x4*)(wfL + k * 8), w1 = *(const LAS f32x4*)(wfL + k * 8 + 4);
                z0 += hv[e] * w0[0]; z1 += hv[e] * w0[1]; z2 += hv[e] * w0[2]; z3 += hv[e] * w0[3];
                z4 += hv[e] * w1[0]; z5 += hv[e] * w1[1]; z6 += hv[e] * w1[2]; z7 += hv[e] * w1[3];
            }
        }
        z0 = wave_sum(z0); z1 = wave_sum(z1); z2 = wave_sum(z2); z3 = wave_sum(z3); z4 = wave_sum(z4); z5 = wave_sum(z5); z6 = wave_sum(z6); z7 = wave_sum(z7);
        float zs = z0; zs = (lane == 1) ? z1 : zs; zs = (lane == 2) ? z2 : zs; zs = (lane == 3) ? z3 : zs; zs = (lane == 4) ? z4 : zs; zs = (lane == 5) ? z5 : zs; zs = (lane == 6) ? z6 : zs; zs = (lane == 7) ? z7 : zs;
        if (lane < 8) {
            const float t = zs + bfv;
            const float lf = fminf(t, 0.f) - log1pf(expf(-fabsf(t)));
            if (m < MP) P.out[O_LFP + (size_t)m * 8 + lane] = lf; else P.out[O_LFS + (size_t)(m - MP) * 8 + lane] = lf;
        }
    }
    const int gt = blockIdx.x * 512 + tid, NT = G * 512;
    for (int c = gt; c < NSB * LAC * 64; c += NT) { conv_chunk(P.cak, (bf16_t*)(P.ws + WS_KAS), c, 9, LAS_LEN); conv_chunk(P.cav, (bf16_t*)(P.ws + WS_VAS), c, 9, LAS_LEN); }
    for (int c = gt; c < NSB * PAST * 64; c += NT) { conv_chunk(P.cbk, (bf16_t*)(P.ws + WS_KBS), c, 11, LBS_LEN); conv_chunk(P.cbv, (bf16_t*)(P.ws + WS_VBS), c, 11, LBS_LEN); }
}

template <int PER, class LD>
__device__ __forceinline__ void block_cumsum(int n, LD load, float* dst, LAS float* red, int tid) {
    const int lane = tid & 63, w = tid >> 6;
    float v[PER]; float run = 0.f;
#pragma unroll
    for (int e = 0; e < PER; ++e) { const int t = tid * PER + e; const float x = (t < n) ? load(t) : 0.f; run += x; v[e] = run; }
    float inc = run;
#pragma unroll
    for (int o = 1; o < 64; o <<= 1) { const float y = __shfl_up(inc, o); if (lane >= o) inc += y; }
    if (lane == 63) red[w] = inc;
    __syncthreads();
    float off = inc - run;
#pragma unroll
    for (int i = 0; i < 8; ++i) off += (i < w) ? red[i] : 0.f;
#pragma unroll
    for (int e = 0; e < PER; ++e) { const int t = tid * PER + e; if (t < n) dst[t] = (v[e] + off) * LOG2E; }
    __syncthreads();
}

namespace att {
constexpr float THR = 8.0f;
__device__ __forceinline__ int crow(int r, int hi) { return (r & 3) + 8 * (r >> 2) + 4 * hi; }
__device__ __forceinline__ float xhalf_max(float m) {
    auto rr = __builtin_amdgcn_permlane32_swap(__float_as_uint(m), __float_as_uint(m), false, false);
    return fmaxf(__uint_as_float(rr[0]), __uint_as_float(rr[1]));
}
__device__ __forceinline__ float xhalf_sum(float m) {
    auto rr = __builtin_amdgcn_permlane32_swap(__float_as_uint(m), __float_as_uint(m), false, false);
    return __uint_as_float(rr[0]) + __uint_as_float(rr[1]);
}

template <int MODE>
__device__ __forceinline__ void unit(const bf16_t* __restrict__ Qrow, const bf16_t* __restrict__ Kb, const bf16_t* __restrict__ Vb, int kb0, int kb1, int qpos0,
                                     const LAS float* tab, bf16_t* Yrow, const bf16_t* __restrict__ Grow, LAS unsigned char* st, int lane) {
    const int r32 = lane & 31, hi = lane >> 5;
    bf16x8 qf[4];
#pragma unroll
    for (int d0 = 0; d0 < 4; ++d0) qf[d0] = *(const bf16x8*)(Qrow + (size_t)r32 * 512 + d0 * 16 + hi * 8);
    const int skey = lane >> 3, sch = lane & 7;
    const int kw0 = skey * 128 + ((sch ^ skey) << 4);
    const int vw0 = 4096 + (sch >> 2) * 512 + skey * 64 + (sch & 3) * 16;
    const bf16_t* kg = Kb + (size_t)skey * 512 + sch * 8;
    const bf16_t* vg = Vb + (size_t)skey * 512 + sch * 8;
    const int kr0 = r32 * 128;
    const unsigned vbase = (unsigned)(unsigned long)(st + 4096) + (unsigned)((4 * hi + ((lane & 15) >> 2)) * 64 + ((lane >> 4) & 1) * 32 + (lane & 3) * 8);
    u32x4 kr[4], vr[4];
#pragma unroll
    for (int i = 0; i < 4; ++i) { kr[i] = *(const u32x4*)(kg + (size_t)(kb0 * 32 + 8 * i) * 512); vr[i] = *(const u32x4*)(vg + (size_t)(kb0 * 32 + 8 * i) * 512); }
    float m = 0.f, l = 0.f; bool first = true;
    f32x16 o0, o1;
#pragma unroll
    for (int r = 0; r < 16; ++r) { o0[r] = 0.f; o1[r] = 0.f; }
    const float cq = (MODE == 1) ? tab[qpos0 + r32] : 0.f;
    const float cfar = (MODE == 0) ? tab[256] : 0.f;
    for (int kb = kb0; kb < kb1; ++kb) {
#pragma unroll
        for (int i = 0; i < 4; ++i) { *(LAS u32x4*)(st + kw0 + i * 1024) = kr[i]; *(LAS u32x4*)(st + vw0 + i * 1024) = vr[i]; }
        if (kb + 1 < kb1) {
#pragma unroll
            for (int i = 0; i < 4; ++i) { kr[i] = *(const u32x4*)(kg + (size_t)((kb + 1) * 32 + 8 * i) * 512); vr[i] = *(const u32x4*)(vg + (size_t)((kb + 1) * 32 + 8 * i) * 512); }
        }
        bf16x8 kf[4];
#pragma unroll
        for (int d0 = 0; d0 < 4; ++d0) kf[d0] = *(const LAS bf16x8*)(st + kr0 + (((d0 * 2 + hi) ^ (r32 & 7)) << 4));
        f32x16 s;
        if (MODE == 1) {
            const float nm = cq - m;
#pragma unroll
            for (int g = 0; g < 4; ++g) { const f32x4 ck = *(const LAS f32x4*)(tab + kb * 32 + 8 * g + 4 * hi);
#pragma unroll
                for (int e = 0; e < 4; ++e) s[4 * g + e] = nm - ck[e]; }
        } else {
            if (qpos0 - (kb * 32 + 31) >= 128) {
                const float c = cfar - m;
#pragma unroll
                for (int r = 0; r < 16; ++r) s[r] = c;
            } else {
                const int dd = qpos0 + r32 - kb * 32 + 128;
#pragma unroll
                for (int r = 0; r < 16; ++r) { int idx = dd - crow(r, hi); idx = idx < 0 ? 0 : (idx > 256 ? 256 : idx); s[r] = tab[idx] - m; }
            }
        }
#pragma unroll
        for (int d0 = 0; d0 < 4; ++d0) s = __builtin_amdgcn_mfma_f32_32x32x16_bf16(kf[d0], qf[d0], s, 0, 0, 0);
        if (MODE == 1 && kb == kb1 - 1) {
#pragma unroll
            for (int r = 0; r < 16; ++r) if (crow(r, hi) > r32) s[r] = -1e30f;
        }
        float rm = fmaxf(fmaxf(s[0], s[1]), fmaxf(s[2], s[3]));
#pragma unroll
        for (int r = 4; r < 16; r += 4) rm = fmaxf(rm, fmaxf(fmaxf(s[r], s[r + 1]), fmaxf(s[r + 2], s[r + 3])));
        rm = xhalf_max(rm);
        if (first) {
            first = false; m = rm;
#pragma unroll
            for (int r = 0; r < 16; ++r) s[r] -= rm;
        } else if (__any(rm > THR)) {
            const float dl = fmaxf(rm, 0.f); m += dl;
            const float f = __builtin_amdgcn_exp2f(-dl); l *= f;
#pragma unroll
            for (int r = 0; r < 16; ++r) { s[r] -= dl; o0[r] *= f; o1[r] *= f; }
        }
        float ls = 0.f;
#pragma unroll
        for (int r = 0; r < 16; ++r) { s[r] = __builtin_amdgcn_exp2f(s[r]); ls += s[r]; }
        l += ls;
        u32x4 pw0, pw1;
        pw0.x = pk2(s[0], s[1]); pw0.y = pk2(s[2], s[3]); pw0.z = pk2(s[4], s[5]); pw0.w = pk2(s[6], s[7]);
        pw1.x = pk2(s[8], s[9]); pw1.y = pk2(s[10], s[11]); pw1.z = pk2(s[12], s[13]); pw1.w = pk2(s[14], s[15]);
        const bf16x8 pf0 = __builtin_bit_cast(bf16x8, pw0), pf1 = __builtin_bit_cast(bf16x8, pw1);
        s16x4 vlo[4], vhi[4];
#define ATT_TR(dst, off) asm volatile("ds_read_b64_tr_b16 %0, %1 offset:%c2" : "=&v"(dst) : "v"(vbase), "i"(off) : "memory")
        ATT_TR(vlo[0], 0);    ATT_TR(vhi[0], 1024);
        ATT_TR(vlo[1], 2048); ATT_TR(vhi[1], 3072);
        ATT_TR(vlo[2], 512);  ATT_TR(vhi[2], 1536);
        ATT_TR(vlo[3], 2560); ATT_TR(vhi[3], 3584);
#undef ATT_TR
        asm volatile("s_waitcnt lgkmcnt(0)" ::: "memory");
        __builtin_amdgcn_sched_barrier(0);
#define ATT_VF(i) (bf16x8){vlo[i][0], vlo[i][1], vlo[i][2], vlo[i][3], vhi[i][0], vhi[i][1], vhi[i][2], vhi[i][3]}
        o0 = __builtin_amdgcn_mfma_f32_32x32x16_bf16(ATT_VF(0), pf0, o0, 0, 0, 0);
        o0 = __builtin_amdgcn_mfma_f32_32x32x16_bf16(ATT_VF(1), pf1, o0, 0, 0, 0);
        o1 = __builtin_amdgcn_mfma_f32_32x32x16_bf16(ATT_VF(2), pf0, o1, 0, 0, 0);
        o1 = __builtin_amdgcn_mfma_f32_32x32x16_bf16(ATT_VF(3), pf1, o1, 0, 0, 0);
#undef ATT_VF
    }
    l = xhalf_sum(l);
    const float inv = 1.0f / l;
#pragma unroll
    for (int db = 0; db < 2; ++db)
#pragma unroll
        for (int g = 0; g < 4; ++g) {
            const int d = 32 * db + 8 * g + 4 * hi;
            const u32x2 gw2 = *(const u32x2*)(Grow + (size_t)r32 * 512 + d);
            const float a0 = (db ? o1[4 * g + 0] : o0[4 * g + 0]) * inv * bf_lo(gw2.x), a1 = (db ? o1[4 * g + 1] : o0[4 * g + 1]) * inv * bf_hi(gw2.x);
            const float a2 = (db ? o1[4 * g + 2] : o0[4 * g + 2]) * inv * bf_lo(gw2.y), a3 = (db ? o1[4 * g + 3] : o0[4 * g + 3]) * inv * bf_hi(gw2.y);
            u32x2 w; w.x = pk2(a0, a1); w.y = pk2(a2, a3);
            *(u32x2*)(Yrow + (size_t)r32 * 1024 + d) = w;
        }
}
}

__device__ __forceinline__ void phase2(const Params& P, LAS unsigned char* lds, int tid, int lane, int wave) {
    LAS float* c2p = (LAS float*)(lds + 65536);
    LAS float* c2s = (LAS float*)(lds + 65536 + 8192);
    LAS float* rb2 = (LAS float*)(lds + 65536 + 8192 + 8448);
    LAS unsigned char* st = lds + wave * 8192;
    for (int vb = blockIdx.x; vb < 256; vb += gridDim.x) {
        const int b = vb >> 3, h = vb & 7;
        __syncthreads();
        {
            const float* C2P = (const float*)(P.ws + WS_C2P); const float* C2S = (const float*)(P.ws + WS_C2S);
            for (int i = tid; i < 2048; i += 512) c2p[i] = C2P[(size_t)vb * 2048 + i];
            if (vb < 64) for (int i = tid; i < LBS_LEN; i += 512) c2s[i] = C2S[(size_t)vb * LBS_LEN + i];
            for (int i = tid; i < NREL; i += 512) rb2[i] = P.relb[h * NREL + i] * LOG2E;
        }
        __syncthreads();
        for (int it = 0; it < 17; ++it) {
            int mode, kb0, kb1, qpos0; size_t qrow, koff, voff; const LAS float* tab;
            if (it == 0) {
                if (wave != 0 || vb >= 128) continue;
                if (vb < 64) { mode = 1; qrow = (size_t)MP + b * NST; koff = WS_KBS + (size_t)b * LBS_LEN * 1024; voff = WS_VBS + (size_t)b * LBS_LEN * 1024; kb0 = 0; kb1 = LBS_LEN / 32; qpos0 = PAST; tab = c2s; }
                else { const int bs = (vb - 64) >> 3; mode = 0; qrow = (size_t)MP + bs * NST; koff = WS_KAS + (size_t)bs * LAS_LEN * 1024; voff = WS_VAS + (size_t)bs * LAS_LEN * 1024; kb0 = 0; kb1 = LAS_LEN / 32; qpos0 = LAC; tab = rb2; }
            } else if (it <= 8) {
                const int j = it - 1, qb = (j & 1) ? (16 * (j >> 1) + 15 - wave) : (16 * (j >> 1) + wave);
                mode = 1; qrow = (size_t)b * SEQ + qb * 32; koff = WS_SEG + 5 * SEG_STRIDE + (size_t)b * SEQ * 1024; voff = WS_SEG + 6 * SEG_STRIDE + (size_t)b * SEQ * 1024; kb0 = 0; kb1 = qb + 1; qpos0 = qb * 32; tab = c2p;
            } else {
                const int hc = wave + 8 * (it - 9), n = hc >> 1;
                mode = 0; qrow = (size_t)b * SEQ + hc * 32; koff = WS_SEG + 1 * SEG_STRIDE + (size_t)b * SEQ * 1024; voff = WS_SEG + 2 * SEG_STRIDE + (size_t)b * SEQ * 1024; kb0 = (2 * n - 16) < 0 ? 0 : (2 * n - 16); kb1 = 2 * n + 2; qpos0 = hc * 32; tab = rb2;
            }
            const size_t segq = WS_SEG + (size_t)(mode ? 4 : 0) * SEG_STRIDE, segg = WS_SEG + (size_t)(mode ? 7 : 3) * SEG_STRIDE;
            const bf16_t* Qrow = (const bf16_t*)(P.ws + segq) + qrow * 512 + h * 64;
            const bf16_t* Grow = (const bf16_t*)(P.ws + segg) + qrow * 512 + h * 64;
            const bf16_t* Kb = (const bf16_t*)(P.ws + koff) + h * 64;
            const bf16_t* Vb = (const bf16_t*)(P.ws + voff) + h * 64;
            bf16_t* Yrow = (bf16_t*)(P.ws + WS_H) + qrow * 1024 + (mode ? 512 : 0) + h * 64;
            if (mode) att::unit<1>(Qrow, Kb, Vb, kb0, kb1, qpos0, tab, Yrow, Grow, st, lane);
            else      att::unit<0>(Qrow, Kb, Vb, kb0, kb1, qpos0, tab, Yrow, Grow, st, lane);
        }
    }
}

__device__ __forceinline__ void phase4(const Params& P, int lane, int wave) {
    const int gw = blockIdx.x * 8 + wave, NGW = gridDim.x * 8;
    const float* ps = (const float*)(P.ws + WS_PS);
    f32x4 g4[4];
#pragma unroll
    for (int j = 0; j < 4; ++j) g4[j] = *(const f32x4*)(P.fgain + 4 * lane + 256 * j);
    for (int m = gw; m < MT; m += NGW) {
        float* row = P.out + (size_t)m * 1024;
        f32x4 v[4];
#pragma unroll
        for (int j = 0; j < 4; ++j) v[j] = *(const f32x4*)(row + 4 * lane + 256 * j);
        float ss = ps[(size_t)m * 16 + (lane & 15)];
        ss += __shfl_xor(ss, 1); ss += __shfl_xor(ss, 2); ss += __shfl_xor(ss, 4); ss += __shfl_xor(ss, 8);
        const float rstd = 1.0f / sqrtf(ss * (1.0f / 1024.0f) + RMS_EPS);
#pragma unroll
        for (int j = 0; j < 4; ++j) *(f32x4*)(row + 4 * lane + 256 * j) = v[j] * rstd * g4[j];
    }
}

#define LOAD_PARAMS() const Params& P = Parg
#define MY_TID() ((int)threadIdx.x)
__global__ void __launch_bounds__(512, 2) hymba_fwd(Params Parg) {
    extern __shared__ __attribute__((aligned(16))) unsigned char lds_raw[];
    LAS unsigned char* lds = (LAS unsigned char*)lds_raw;
    cg::grid_group grid = cg::this_grid();
    const int wave = __builtin_amdgcn_readfirstlane((int)threadIdx.x >> 6);

    {   LOAD_PARAMS(); const int tid = MY_TID();
        phase0(P, lds, tid, tid & 63, wave); }
    grid.sync();

    {
        LOAD_PARAMS(); const int tid = MY_TID();
        LAS float* red = (LAS float*)(lds);
        for (int u = blockIdx.x; u < 256; u += gridDim.x) {
            const int b = u >> 3, h = u & 7;
            const float* src = P.out + O_LFP + ((size_t)b * SEQ) * 8 + h;
            block_cumsum<4>(SEQ, [&](int t) { return src[(size_t)t * 8]; }, (float*)(P.ws + WS_C2P) + (size_t)u * 2048, red, tid);
        }
        for (int u = blockIdx.x; u < 64; u += gridDim.x) {
            const int b = u >> 3, h = u & 7;
            const float* src0 = P.cblf + ((size_t)b * PAST) * 8 + h;
            const float* src1 = P.out + O_LFS + ((size_t)b * NST) * 8 + h;
            block_cumsum<5>(LBS_LEN, [&](int t) { return t < PAST ? src0[(size_t)t * 8] : src1[(size_t)(t - PAST) * 8]; }, (float*)(P.ws + WS_C2S) + (size_t)u * LBS_LEN, red, tid);
        }
        pg8::Gemm g{(const bf16_t*)(P.ws + WS_H), (const bf16_t*)(P.ws + WS_WIN), MT, 4096, 1024};
        pg8::StaticOrder S; S.init(MT, 4096, (int)gridDim.x, (int)blockIdx.x);
        EpiProj E{P.ws, P.out};
        pg8::gemm_phase<EpiProj, pg8::StaticOrder, true, true>(lds, g, S, E, tid);
    }
    grid.sync();

    {   LOAD_PARAMS(); const int tid = MY_TID();
        phase2(P, lds, tid, tid & 63, wave); }
    grid.sync();

    {
        LOAD_PARAMS(); const int tid = MY_TID();
        pg8::Gemm g{(const bf16_t*)(P.ws + WS_H), (const bf16_t*)(P.ws + WS_WOUT), MT, 1024, 1024};
        pg8::StaticOrder S; S.init(MT, 1024, (int)gridDim.x, (int)blockIdx.x);
        EpiOut E{P.xp, P.xs, P.out, (float*)(P.ws + WS_PS)};
        pg8::gemm_phase<EpiOut, pg8::StaticOrder, true, true>(lds, g, S, E, tid);
    }
    grid.sync();

    {   LOAD_PARAMS(); const int tid = MY_TID();
        phase4(P, (int)__builtin_amdgcn_mbcnt_hi(~0u, __builtin_amdgcn_mbcnt_lo(~0u, 0u)), wave); }
}

extern "C" void kernel_launch(void* const* d_in, const int* in_sizes, int n_in, void* d_out, int out_size, void* d_ws, size_t ws_size, hipStream_t stream) {
    static int grid = 0;
    if (grid == 0) {
        if (n_in != 13 || in_sizes[0] != MP * 1024 || (size_t)out_size != O_END || ws_size < WS_END) {
            fprintf(stderr, "kernel_launch: shape mismatch: n_in %d in0 %d out %d (want %zu) ws %zu (want %zu)\n", n_in, n_in > 0 ? in_sizes[0] : -1, out_size, (size_t)O_END, ws_size, (size_t)WS_END);
            grid = -1; return;
        }
        int dev = 0, cus = 0, per_cu = 0;
        hipGetDevice(&dev);
        hipDeviceGetAttribute(&cus, hipDeviceAttributeMultiprocessorCount, dev);
        hipFuncSetAttribute((const void*)hymba_fwd, hipFuncAttributeMaxDynamicSharedMemorySize, LDS_BYTES);
        hipOccupancyMaxActiveBlocksPerMultiprocessor(&per_cu, (const void*)hymba_fwd, 512, LDS_BYTES);
        if (per_cu < 1 || cus < 1) { fprintf(stderr, "kernel_launch: occupancy query gave %d blocks/CU on %d CUs\n", per_cu, cus); grid = -1; return; }
        grid = cus * per_cu;
        if (grid > 256) grid = 256;
    }
    if (grid < 0) return;
    Params p{};
    p.xp = (const float*)d_in[0]; p.xs = (const float*)d_in[1]; p.cak = (const float*)d_in[2]; p.cav = (const float*)d_in[3]; p.cbk = (const float*)d_in[4]; p.cbv = (const float*)d_in[5];
    p.cblf = (const float*)d_in[6]; p.gain = (const float*)d_in[7]; p.win = (const float*)d_in[8]; p.bfg = (const float*)d_in[9]; p.relb = (const float*)d_in[10]; p.wout = (const float*)d_in[11];
    p.fgain = (const float*)d_in[12]; p.out = (float*)d_out; p.ws = (unsigned char*)d_ws;
    void* args[] = {&p};
    hipError_t e = hipLaunchCooperativeKernel((const void*)hymba_fwd, dim3(grid), dim3(512), args, LDS_BYTES, stream);
    if (e != hipSuccess) fprintf(stderr, "cooperative launch failed: %s (grid %d)\n", hipGetErrorString(e), grid);
}
```

```cpp
#include <hip/hip_runtime.h>
#include <hip/hip_cooperative_groups.h>
#include <cstdio>
#include <cstdint>
namespace cg = cooperative_groups;
namespace pg8 {
#define PG8_LAS __attribute__((address_space(3)))
typedef unsigned short bf16_t;
typedef short bf16x8 __attribute__((ext_vector_type(8)));
typedef float f32x4 __attribute__((ext_vector_type(4)));
typedef unsigned u32x4 __attribute__((ext_vector_type(4)));
constexpr int BM = 256, BK = 64, HALF = 128, HTB = HALF * BK * 2  , STAGE_BYTES = 8 * HTB, NXCD = 8, WGM = 8;

__host__ __device__ __forceinline__ int lds_byte(int r, int c) { const int st = (r >> 4) * 2 + (c >> 5), rr = r & 15, cc = c & 31, ob = rr * 64 + cc * 2; return st * 1024 + (ob ^ (((ob >> 9) & 1) << 5)); }
__host__ __device__ __forceinline__ void stage_rc(int b, int& R, int& C) { const int st = b / 1024, sb = b % 1024, swz = sb ^ (((sb >> 9) & 1) << 5); R = (st >> 1) * 16 + swz / 64; C = (st & 1) * 32 + (swz % 64) / 2; }
__host__ __device__ __forceinline__ int perm32(int rho) { const int n = rho >> 4, i = rho & 15; return 8 * (i >> 2) + 4 * n + (i & 3); }

struct Unit { int pm, pn; };
struct Gemm { const bf16_t* A; const bf16_t* Bt; int M, N, K; };

struct StaticOrder {
    int nM, nN, nwg, G, c;
    __host__ __device__ void init(int M, int N, int G_, int c_) { nM = M / BM; nN = N / BM; nwg = nM * nN; G = G_; c = c_; }
    __host__ __device__ bool next(int i, Unit& u) const {
        const long L = (long)i * G + c; if (L >= nwg) return false;
        int wgid = (int)L; { const int q = nwg / NXCD, r = nwg % NXCD, xcd = wgid % NXCD, off = wgid / NXCD; wgid = (xcd < r ? xcd * (q + 1) : r * (q + 1) + (xcd - r) * q) + off; }
        const int nig = WGM * nN, gid = wgid / nig, fm = gid * WGM, gsz = (nM - fm) < WGM ? (nM - fm) : WGM;
        u.pm = fm + ((wgid % nig) % gsz); u.pn = (wgid % nig) / gsz; return true;
    }
    __device__ __forceinline__ void a_ready(const Unit&) const {}
    __device__ __forceinline__ void done(const Unit&) const {}
};
__device__ __forceinline__ unsigned cvt_pk_bf16(float lo, float hi) { unsigned r; asm volatile("v_cvt_pk_bf16_f32 %0, %1, %2" : "=v"(r) : "v"(lo), "v"(hi)); return r; }
typedef float f32x2 __attribute__((ext_vector_type(2)));
template <class Epi, class Sched, bool ALIGN_EPI = false, bool SP2 = false>
__device__ __forceinline__ void gemm_phase(PG8_LAS unsigned char* lds, const Gemm g, const Sched& S, const Epi& E, const int tid) {
    const int wid = __builtin_amdgcn_readfirstlane(tid >> 6), lane = tid & 63, wr = wid >> 2, wc = wid & 3, fr = lane & 15, fq = lane >> 4;
    const int K = g.K, nt = K / BK;
    unsigned voffA[2], voffB[2];
#pragma unroll
    for (int i = 0; i < 2; ++i) { int R, C; stage_rc(tid * 16 + i * 8192, R, C); const int Rb = Epi::PERM ? ((R & ~31) + perm32(R & 31)) : R;
        voffA[i] = (unsigned)(R * K + C) * 2u; voffB[i] = (unsigned)(Rb * K + C) * 2u; }
    const size_t kstep = (size_t)(BK * 2);
    const size_t hstep = (size_t)HALF * K * 2;
    const size_t tstep = 2 * hstep;
    const unsigned ldsw = (unsigned)wid * 1024u;
    const int aoff = lds_byte(wr * 64 + fr, fq * 8), boff = lds_byte(wc * 32 + fr, fq * 8);
#define PG8_SA(b, h) (((b) * 2 + (h)) * HTB)
#define PG8_SB(b, h) ((4 + (b) * 2 + (h)) * HTB)
#define PG8_STAGE(bufoff, gbase, voff) do { _Pragma("unroll") for (int _i = 0; _i < 2; ++_i) \
        __builtin_amdgcn_global_load_lds((const unsigned*)((const char*)(gbase) + (voff)[_i]), (PG8_LAS unsigned*)(lds + (bufoff) + ldsw + _i * 8192), 16, 0, 0); } while (0)
#define PG8_LDA(dst, b, h) do { _Pragma("unroll") for (int m = 0; m < 4; ++m) _Pragma("unroll") for (int k = 0; k < 2; ++k) dst[m][k] = *(const PG8_LAS bf16x8*)(lds + PG8_SA(b, h) + aoff + m * 2048 + k * 1024); } while (0)
#define PG8_LDB(dst, b, h) do { _Pragma("unroll") for (int n = 0; n < 2; ++n) _Pragma("unroll") for (int k = 0; k < 2; ++k) dst[n][k] = *(const PG8_LAS bf16x8*)(lds + PG8_SB(b, h) + boff + n * 2048 + k * 1024); } while (0)
#define PG8_MMA(ai, bj, At, Bt) do { __builtin_amdgcn_s_setprio(1); _Pragma("unroll") for (int m = 0; m < 4; ++m) _Pragma("unroll") for (int n = 0; n < 2; ++n) _Pragma("unroll") for (int k = 0; k < 2; ++k) \
        acc[ai][bj][m][n] = __builtin_amdgcn_mfma_f32_16x16x32_bf16(Bt[n][k], At[m][k], acc[ai][bj][m][n], 0, 0, 0); __builtin_amdgcn_s_setprio(0); } while (0)
#define PG8_WAIT_V(n) asm volatile("s_waitcnt vmcnt(" #n ")" ::: "memory")
#define PG8_WAIT_L(n) asm volatile("s_waitcnt lgkmcnt(" #n ")" ::: "memory")
#define PG8_BAR __builtin_amdgcn_s_barrier()
#define PG8_SCHED __builtin_amdgcn_sched_barrier(0)
    Unit cur, nxt; int ui = 0;
    if (!S.next(0, cur)) return;
    f32x4 acc[2][2][4][2];
#pragma unroll
    for (int a = 0; a < 2; ++a)
#pragma unroll
        for (int b = 0; b < 2; ++b)
#pragma unroll
            for (int m = 0; m < 4; ++m)
#pragma unroll
                for (int n = 0; n < 2; ++n) acc[a][b][m][n] = (f32x4){0.f, 0.f, 0.f, 0.f};
    bf16x8 At[4][2], B0[2][2], B1[2][2];
    const char* cA = (const char*)g.A + (size_t)cur.pm * tstep; const char* cB = (const char*)g.Bt + (size_t)cur.pn * tstep;
    S.a_ready(cur);
    if constexpr (SP2) {
        PG8_STAGE(PG8_SB(0, 0), cB, voffB); PG8_STAGE(PG8_SB(0, 1), cB + hstep, voffB); PG8_STAGE(PG8_SA(0, 0), cA, voffA); PG8_STAGE(PG8_SA(0, 1), cA + hstep, voffA);
        if (wr == 1) PG8_BAR;
        PG8_WAIT_V(2); PG8_BAR;
        PG8_STAGE(PG8_SB(1, 0), cB + kstep, voffB); PG8_STAGE(PG8_SA(1, 0), cA + kstep, voffA); PG8_STAGE(PG8_SB(1, 1), cB + hstep + kstep, voffB);
        PG8_WAIT_V(6); PG8_BAR;
    } else {
        PG8_STAGE(PG8_SB(0, 0), cB, voffB); PG8_STAGE(PG8_SA(0, 0), cA, voffA); PG8_STAGE(PG8_SB(0, 1), cB + hstep, voffB); PG8_STAGE(PG8_SA(0, 1), cA + hstep, voffA);
        if (wr == 1) PG8_BAR;
        PG8_WAIT_V(4); PG8_BAR;
        PG8_STAGE(PG8_SB(1, 0), cB + kstep, voffB); PG8_STAGE(PG8_SA(1, 0), cA + kstep, voffA); PG8_STAGE(PG8_SB(1, 1), cB + hstep + kstep, voffB);
        PG8_WAIT_V(6); PG8_BAR;
    }
    for (;;) {
        const bool has_next = S.next(ui + 1, nxt);
        const char* nA = has_next ? (const char*)g.A + (size_t)nxt.pm * tstep : cA; const char* nB = has_next ? (const char*)g.Bt + (size_t)nxt.pn * tstep : cB;
        for (int t = 0; t < nt; t += 2) {
            const bool last = (t == nt - 2);
            const char* a1 = cA + (size_t)(t + 1) * kstep;
            const char* a2 = last ? nA : cA + (size_t)(t + 2) * kstep; const char* b2 = last ? nB : cB + (size_t)(t + 2) * kstep;
            const char* a3 = a2 + kstep; const char* b3 = b2 + kstep;
            if (last && has_next) S.a_ready(nxt);
            if constexpr (SP2) {
            PG8_LDB(B0, 0, 0); PG8_LDB(B1, 0, 1); PG8_SCHED; PG8_LDA(At, 0, 0); PG8_STAGE(PG8_SA(1, 1), a1 + hstep, voffA);
            PG8_WAIT_V(8); PG8_WAIT_L(0); PG8_BAR; PG8_MMA(0, 0, At, B0); PG8_MMA(0, 1, At, B1); PG8_BAR; PG8_SCHED;
            PG8_LDA(At, 0, 1); PG8_STAGE(PG8_SB(0, 0), b2, voffB); PG8_STAGE(PG8_SB(0, 1), b2 + hstep, voffB); PG8_STAGE(PG8_SA(0, 0), a2, voffA);
            PG8_WAIT_V(8); PG8_WAIT_L(0); PG8_BAR; PG8_MMA(1, 0, At, B0); PG8_MMA(1, 1, At, B1); PG8_BAR; PG8_SCHED;
            PG8_LDB(B0, 1, 0); PG8_LDB(B1, 1, 1); PG8_SCHED; PG8_LDA(At, 1, 0); PG8_STAGE(PG8_SA(0, 1), a2 + hstep, voffA);
            PG8_WAIT_V(8); PG8_WAIT_L(0); PG8_BAR; PG8_MMA(0, 0, At, B0); PG8_MMA(0, 1, At, B1); PG8_BAR; PG8_SCHED;
            PG8_LDA(At, 1, 1); PG8_STAGE(PG8_SB(1, 0), b3, voffB); PG8_STAGE(PG8_SB(1, 1), b3 + hstep, voffB); PG8_STAGE(PG8_SA(1, 0), a3, voffA);
            PG8_WAIT_V(8); PG8_WAIT_L(0); PG8_BAR; PG8_MMA(1, 0, At, B0); PG8_MMA(1, 1, At, B1); PG8_BAR; PG8_SCHED;
            } else {
            PG8_LDB(B0, 0, 0); PG8_SCHED; PG8_LDA(At, 0, 0); PG8_STAGE(PG8_SA(1, 1), a1 + hstep, voffA);
            PG8_WAIT_L(8); PG8_BAR; PG8_WAIT_L(0); PG8_MMA(0, 0, At, B0); PG8_BAR; PG8_SCHED;
            PG8_LDB(B1, 0, 1); PG8_STAGE(PG8_SB(0, 0), b2, voffB);
            PG8_BAR; PG8_WAIT_L(0); PG8_MMA(0, 1, At, B1); PG8_BAR;
            PG8_LDA(At, 0, 1); PG8_STAGE(PG8_SA(0, 0), a2, voffA);
            PG8_BAR; PG8_WAIT_L(0); PG8_MMA(1, 0, At, B0); PG8_BAR; PG8_SCHED;
            PG8_STAGE(PG8_SB(0, 1), b2 + hstep, voffB);
            PG8_WAIT_V(6); PG8_BAR; PG8_MMA(1, 1, At, B1); PG8_BAR;
            PG8_LDB(B0, 1, 0); PG8_SCHED; PG8_LDA(At, 1, 0); PG8_STAGE(PG8_SA(0, 1), a2 + hstep, voffA);
            PG8_WAIT_L(8); PG8_BAR; PG8_WAIT_L(0); PG8_MMA(0, 0, At, B0); PG8_BAR; PG8_SCHED;
            PG8_LDB(B1, 1, 1); PG8_STAGE(PG8_SB(1, 0), b3, voffB);
            PG8_BAR; PG8_WAIT_L(0); PG8_MMA(0, 1, At, B1); PG8_BAR;
            PG8_LDA(At, 1, 1); PG8_STAGE(PG8_SA(1, 0), a3, voffA);
            PG8_BAR; PG8_WAIT_L(0); PG8_MMA(1, 0, At, B0); PG8_BAR; PG8_SCHED;
            PG8_STAGE(PG8_SB(1, 1), b3 + hstep, voffB);
            PG8_WAIT_V(6); PG8_BAR; PG8_MMA(1, 1, At, B1); PG8_BAR;
            }
        }
        if constexpr (ALIGN_EPI) { if (wr == 0) PG8_BAR; }
        if constexpr (!Epi::AFTER_DRAIN) { E(acc, cur, wr, wc, fr, fq); S.done(cur); }
        if (!has_next) break;
#pragma unroll
        for (int a = 0; a < 2; ++a)
#pragma unroll
            for (int b = 0; b < 2; ++b)
#pragma unroll
                for (int m = 0; m < 4; ++m)
#pragma unroll
                    for (int n = 0; n < 2; ++n) acc[a][b][m][n] = (f32x4){0.f, 0.f, 0.f, 0.f};
        cur = nxt; cA = nA; cB = nB; ++ui;
        if constexpr (ALIGN_EPI) { if (wr == 1) PG8_BAR; }
    }
    PG8_WAIT_V(0);
    if constexpr (!ALIGN_EPI) { if (wr == 0) PG8_BAR; }
    PG8_BAR;
    if constexpr (Epi::AFTER_DRAIN) { E.fused(acc, cur, wr, wc, fr, fq, lds, wid, lane); S.done(cur); }
#undef PG8_SA
#undef PG8_SB
#undef PG8_STAGE
#undef PG8_LDA
#undef PG8_LDB
#undef PG8_MMA
#undef PG8_WAIT_V
#undef PG8_WAIT_L
#undef PG8_BAR
#undef PG8_SCHED
}
}

#define LAS __attribute__((address_space(3)))
typedef unsigned short bf16_t;
typedef short bf16x8 __attribute__((ext_vector_type(8)));
typedef short s16x4 __attribute__((ext_vector_type(4)));
typedef float f32x4 __attribute__((ext_vector_type(4)));
typedef float f32x16 __attribute__((ext_vector_type(16)));
typedef unsigned u32x4 __attribute__((ext_vector_type(4)));
typedef unsigned u32x2 __attribute__((ext_vector_type(2)));

constexpr int DM = 1024, NB = 32, SEQ = 2048, MP = NB * SEQ, NSB = 8, NST = 32, MS = NSB * NST, MT = MP + MS;
constexpr int PAST = 2048, LAC = 512, DIN = 4104, NREL = 257;
constexpr int LAS_LEN = LAC + NST  , LBS_LEN = PAST + NST  ;
constexpr float LOG2E = 1.4426950408889634f, QSCALE = 0.125f * LOG2E, RMS_EPS = 1e-6f;

constexpr size_t O_Y = 0;
constexpr size_t O_AKP = (size_t)MT * 1024;
constexpr size_t O_AVP = O_AKP + (size_t)NB * 512 * 512;
constexpr size_t O_BKP = O_AVP + (size_t)NB * 512 * 512;
constexpr size_t O_BVP = O_BKP + (size_t)MP * 512;
constexpr size_t O_LFP = O_BVP + (size_t)MP * 512;
constexpr size_t O_AKS = O_LFP + (size_t)MP * 8;
constexpr size_t O_AVS = O_AKS + (size_t)MS * 512;
constexpr size_t O_BKS = O_AVS + (size_t)MS * 512;
constexpr size_t O_BVS = O_BKS + (size_t)MS * 512;
constexpr size_t O_LFS = O_BVS + (size_t)MS * 512;
constexpr size_t O_END = O_LFS + (size_t)MS * 8;

constexpr size_t MiB = 1u << 20;
constexpr size_t WS_WIN = 0, WS_WOUT = 8 * MiB, WS_C2P = 10 * MiB, WS_C2S = 12 * MiB, WS_PS = 13 * MiB;
constexpr size_t WS_KAS = 18 * MiB, WS_VAS = 23 * MiB, WS_KBS = 28 * MiB, WS_VBS = 45 * MiB;
constexpr size_t WS_H = 64 * MiB;
constexpr size_t WS_SEG = 200 * MiB, SEG_STRIDE = 66 * MiB;
constexpr size_t WS_END = WS_SEG + 8 * SEG_STRIDE;
static_assert((size_t)33 * 8 * 2048 * 64 * 2 <= SEG_STRIDE && (size_t)MT * 1024 * 2 <= WS_SEG - WS_H && (size_t)MT * 64 <= WS_KAS - WS_PS, "ws map");
static_assert((size_t)NSB * LAS_LEN * 512 * 2 <= 5 * MiB && (size_t)NSB * LBS_LEN * 512 * 2 <= 17 * MiB, "ws map");

constexpr int LDS_BYTES = 147456;

struct Params {
    const float* xp; const float* xs; const float* cak; const float* cav; const float* cbk; const float* cbv; const float* cblf;
    const float* gain; const float* win; const float* bfg; const float* relb; const float* wout; const float* fgain;
    float* out; unsigned char* ws;
};

__device__ __forceinline__ float wave_sum(float v) {
#pragma unroll
    for (int o = 1; o < 64; o <<= 1) v += __shfl_xor(v, o);
    return v;
}
typedef float f32x2_t __attribute__((ext_vector_type(2))); typedef __bf16 bf16x2_t __attribute__((ext_vector_type(2)));
__device__ __forceinline__ unsigned pk2(float lo, float hi) { f32x2_t v = {lo, hi}; bf16x2_t b = __builtin_convertvector(v, bf16x2_t); return __builtin_bit_cast(unsigned, b); }
__device__ __forceinline__ float bf_lo(unsigned w) { return __uint_as_float(w << 16); }
__device__ __forceinline__ float bf_hi(unsigned w) { return __uint_as_float(w & 0xffff0000u); }

struct EpiProj {
    static constexpr bool PERM = true, AFTER_DRAIN = false;
    unsigned char* ws; float* out;
    __device__ __forceinline__ void operator()(const pg8::f32x4 (&acc)[2][2][4][2], const pg8::Unit& u, int wr, int wc, int fr, int fq) const {
        const int seg = u.pn >> 1, kind = seg & 3, grp = seg >> 2;
        const bool smp = (u.pm == MP / 256);
        const bool kv = (kind == 1 || kind == 2);
        const int colw = (u.pn & 1) * 256 + wc * 32 + 8 * fq;
        bf16_t* bbase = (bf16_t*)(ws + WS_SEG + (size_t)seg * SEG_STRIDE);
        int sL = 0, sP = 0;
        if (smp && kv) {
            if (grp == 0) { bbase = (bf16_t*)(ws + (kind == 1 ? WS_KAS : WS_VAS)); sL = LAS_LEN; sP = LAC; }
            else          { bbase = (bf16_t*)(ws + (kind == 1 ? WS_KBS : WS_VBS)); sL = LBS_LEN; sP = PAST; }
        }
        float* fdst = nullptr; unsigned frow0 = 0;
        if (kv) {
            if (smp) { fdst = out + (grp == 0 ? (kind == 1 ? O_AKS : O_AVS) : (kind == 1 ? O_BKS : O_BVS)); }
            else if (grp == 1) { fdst = out + (kind == 1 ? O_BKP : O_BVP); frow0 = (unsigned)u.pm * 256u; }
            else if ((u.pm & 7) >= 6) { fdst = out + (kind == 1 ? O_AKP : O_AVP); frow0 = (unsigned)(u.pm >> 3) * 512u + (unsigned)((u.pm & 7) - 6) * 256u; }
        }
        const int hd0 = (u.pn & 1) * 4 + (wc >> 1), dcol = (wc & 1) * 32 + 8 * fq;
        const unsigned bat = (unsigned)(u.pm >> 3), t0 = (unsigned)(u.pm & 7) * 256u;
#pragma unroll
        for (int ai = 0; ai < 2; ++ai)
#pragma unroll
            for (int m = 0; m < 4; ++m) {
                const int rt = ai * 128 + wr * 64 + m * 16 + fr;
#pragma unroll
                for (int bj = 0; bj < 2; ++bj) {
                    const unsigned head = (unsigned)(hd0 + 2 * bj);
                    const unsigned bidx = sL ? ((((unsigned)(rt >> 5) * 8u + head) * (unsigned)sL + (unsigned)(sP + (rt & 31))) * 64u + (unsigned)dcol)
                                             : (((bat * 8u + head) * 2048u + t0 + (unsigned)rt) * 64u + (unsigned)dcol);
                    pg8::f32x4 v0 = acc[ai][bj][m][0], v1 = acc[ai][bj][m][1];
                    if (fdst) { float* fp = fdst + ((frow0 + (unsigned)rt) * 512u + (unsigned)(colw + bj * 128)); *(pg8::f32x4*)fp = v0; *(pg8::f32x4*)(fp + 4) = v1; }
                    if (kind == 0) { v0 = v0 * QSCALE; v1 = v1 * QSCALE; }
                    else if (kind == 3) {
#pragma unroll
                        for (int e = 0; e < 4; ++e) {
                            v0[e] = v0[e] * __builtin_amdgcn_rcpf(1.0f + __builtin_amdgcn_exp2f(-LOG2E * v0[e]));
                            v1[e] = v1[e] * __builtin_amdgcn_rcpf(1.0f + __builtin_amdgcn_exp2f(-LOG2E * v1[e]));
                        }
                    }
                    pg8::u32x4 w; w.x = pk2(v0[0], v0[1]); w.y = pk2(v0[2], v0[3]); w.z = pk2(v1[0], v1[1]); w.w = pk2(v1[2], v1[3]);
                    *(pg8::u32x4*)(bbase + bidx) = w;
                }
            }
    }
};

struct EpiOut {
    static constexpr bool PERM = true, AFTER_DRAIN = false;
    bf16_t* mo;
    __device__ __forceinline__ void operator()(const pg8::f32x4 (&acc)[2][2][4][2], const pg8::Unit& u, int wr, int wc, int fr, int fq) const {
        const unsigned c0 = (unsigned)(u.pn * 256 + wc * 32 + 8 * fq);
#pragma unroll
        for (int ai = 0; ai < 2; ++ai)
#pragma unroll
            for (int m = 0; m < 4; ++m) {
                const unsigned grow = (unsigned)u.pm * 256u + (unsigned)(ai * 128 + wr * 64 + m * 16 + fr);
#pragma unroll
                for (int bj = 0; bj < 2; ++bj) {
                    const pg8::f32x4 v0 = acc[ai][bj][m][0], v1 = acc[ai][bj][m][1];
                    pg8::u32x4 w; w.x = pk2(v0[0], v0[1]); w.y = pk2(v0[2], v0[3]); w.z = pk2(v1[0], v1[1]); w.w = pk2(v1[2], v1[3]);
                    *(pg8::u32x4*)(mo + (grow * 1024u + c0 + (unsigned)(bj * 128))) = w;
                }
            }
    }
};

__device__ __forceinline__ void p0_transpose_item(const float* W, int ldw, int ncols, int K, bf16_t* WT, LAS float* scr, int item, int lane) {
    const int nblk = ncols / 32, kb = item / nblk, nb = item % nblk, k0 = 64 * kb, n0 = 32 * nb;
#pragma unroll 8
    for (int i = 0; i < 32; ++i) { const int kk = 2 * i + (lane >> 5); scr[kk * 33 + (lane & 31)] = W[(size_t)(k0 + kk) * ldw + n0 + (lane & 31)]; }
    asm volatile("s_waitcnt lgkmcnt(0)" ::: "memory");
    const int c = lane & 7;
#pragma unroll
    for (int j = 0; j < 4; ++j) { const int n = (lane >> 3) + 8 * j; const LAS float* s = scr + (8 * c) * 33 + n;
        u32x4 o; o.x = pk2(s[0 * 33], s[1 * 33]); o.y = pk2(s[2 * 33], s[3 * 33]); o.z = pk2(s[4 * 33], s[5 * 33]); o.w = pk2(s[6 * 33], s[7 * 33]);
        *(u32x4*)(WT + (size_t)(n0 + n) * K + k0 + 8 * c) = o; }
    asm volatile("s_waitcnt lgkmcnt(0)" ::: "memory");
}

__device__ __forceinline__ void conv_chunk(const float* src, bf16_t* dst, int c, int pshift, int L) {
    const int row = c >> 6, col8 = c & 63, b = row >> pshift, pos = row & ((1 << pshift) - 1);
    const f32x4 a = *(const f32x4*)(src + (size_t)c * 8), d = *(const f32x4*)(src + (size_t)c * 8 + 4);
    u32x4 o; o.x = pk2(a[0], a[1]); o.y = pk2(a[2], a[3]); o.z = pk2(d[0], d[1]); o.w = pk2(d[2], d[3]);
    *(u32x4*)(dst + (((size_t)(b * 8 + (col8 >> 3)) * L + pos) * 64 + (col8 & 7) * 8)) = o;
}

__device__ __forceinline__ void phase0(const Params& P, LAS unsigned char* lds, int tid, int lane, int wave) {
    const int G = gridDim.x, gw = blockIdx.x * 8 + wave, NGW = G * 8;
    bf16_t* Win_t = (bf16_t*)(P.ws + WS_WIN); bf16_t* Wout_t = (bf16_t*)(P.ws + WS_WOUT); bf16_t* H = (bf16_t*)(P.ws + WS_H);
    LAS float* wfL = (LAS float*)(lds + 69632);
    for (int i = tid; i < 1024 * 8; i += 512) wfL[i] = P.win[(size_t)(i >> 3) * DIN + 4096 + (i & 7)];
    LAS float* scr = (LAS float*)(lds + wave * 8704);
    for (int it = gw; it < 2048 + 512; it += NGW) {
        if (it < 2048) p0_transpose_item(P.win, DIN, 4096, 1024, Win_t, scr, it, lane);
        else p0_transpose_item(P.wout, 1024, 1024, 1024, Wout_t, scr, it - 2048, lane);
    }
    __syncthreads();
    f32x4 g4[4];
#pragma unroll
    for (int j = 0; j < 4; ++j) g4[j] = *(const f32x4*)(P.gain + 4 * lane + 256 * j);
    const float bfv = P.bfg[lane & 7];
    for (int m = gw; m < MT; m += NGW) {
        const float* xrow = (m < MP) ? P.xp + (size_t)m * 1024 : P.xs + (size_t)(m - MP) * 1024;
        f32x4 v[4]; float ss = 0.f;
#pragma unroll
        for (int j = 0; j < 4; ++j) { v[j] = *(const f32x4*)(xrow + 4 * lane + 256 * j); ss += (v[j][0] * v[j][0] + v[j][1] * v[j][1]) + (v[j][2] * v[j][2] + v[j][3] * v[j][3]); }
        ss = wave_sum(ss);
        const float rstd = 1.0f / sqrtf(ss * (1.0f / 1024.0f) + RMS_EPS);
        float z0 = 0.f, z1 = 0.f, z2 = 0.f, z3 = 0.f, z4 = 0.f, z5 = 0.f, z6 = 0.f, z7 = 0.f;
#pragma unroll
        for (int j = 0; j < 4; ++j) {
            const f32x4 hv = v[j] * rstd * g4[j];
            u32x2 w; w.x = pk2(hv[0], hv[1]); w.y = pk2(hv[2], hv[3]);
            *(u32x2*)(H + (size_t)m * 1024 + 4 * lane + 256 * j) = w;
#pragma unroll
            for (int e = 0; e < 4; ++e) {
                const int k = 4 * lane + 256 * j + e;
                const f32x4 w0 = *(const LAS f32x4*)(wfL + k * 8), w1 = *(const LAS f32x4*)(wfL + k * 8 + 4);
                z0 += hv[e] * w0[0]; z1 += hv[e] * w0[1]; z2 += hv[e] * w0[2]; z3 += hv[e] * w0[3];
                z4 += hv[e] * w1[0]; z5 += hv[e] * w1[1]; z6 += hv[e] * w1[2]; z7 += hv[e] * w1[3];
            }
        }
        z0 = wave_sum(z0); z1 = wave_sum(z1); z2 = wave_sum(z2); z3 = wave_sum(z3); z4 = wave_sum(z4); z5 = wave_sum(z5); z6 = wave_sum(z6); z7 = wave_sum(z7);
        float zs = z0; zs = (lane == 1) ? z1 : zs; zs = (lane == 2) ? z2 : zs; zs = (lane == 3) ? z3 : zs; zs = (lane == 4) ? z4 : zs; zs = (lane == 5) ? z5 : zs; zs = (lane == 6) ? z6 : zs; zs = (lane == 7) ? z7 : zs;
        if (lane < 8) {
            const float t = zs + bfv;
            const float lf = fminf(t, 0.f) - log1pf(expf(-fabsf(t)));
            if (m < MP) P.out[O_LFP + (size_t)m * 8 + lane] = lf; else P.out[O_LFS + (size_t)(m - MP) * 8 + lane] = lf;
        }
    }
    const int gt = blockIdx.x * 512 + tid, NT = G * 512;
    for (int c = gt; c < NSB * LAC * 64; c += NT) { conv_chunk(P.cak, (bf16_t*)(P.ws + WS_KAS), c, 9, LAS_LEN); conv_chunk(P.cav, (bf16_t*)(P.ws + WS_VAS), c, 9, LAS_LEN); }
    for (int c = gt; c < NSB * PAST * 64; c += NT) { conv_chunk(P.cbk, (bf16_t*)(P.ws + WS_KBS), c, 11, LBS_LEN); conv_chunk(P.cbv, (bf16_t*)(P.ws + WS_VBS), c, 11, LBS_LEN); }
}

template <int PER, class LD>
__device__ __forceinline__ void block_cumsum(int n, LD load, float* dst, LAS float* red, int tid) {
    const int lane = tid & 63, w = tid >> 6;
    float v[PER]; float run = 0.f;
#pragma unroll
    for (int e = 0; e < PER; ++e) { const int t = tid * PER + e; const float x = (t < n) ? load(t) : 0.f; run += x; v[e] = run; }
    float inc = run;
#pragma unroll
    for (int o = 1; o < 64; o <<= 1) { const float y = __shfl_up(inc, o); if (lane >= o) inc += y; }
    if (lane == 63) red[w] = inc;
    __syncthreads();
    float off = inc - run;
#pragma unroll
    for (int i = 0; i < 8; ++i) off += (i < w) ? red[i] : 0.f;
#pragma unroll
    for (int e = 0; e < PER; ++e) { const int t = tid * PER + e; if (t < n) dst[t] = (v[e] + off) * LOG2E; }
    __syncthreads();
}

namespace att {
constexpr float THR = 8.0f;
__device__ __forceinline__ int crow(int r, int hi) { return (r & 3) + 8 * (r >> 2) + 4 * hi; }
__device__ __forceinline__ float xhalf_max(float m) {
    auto rr = __builtin_amdgcn_permlane32_swap(__float_as_uint(m), __float_as_uint(m), false, false);
    return fmaxf(__uint_as_float(rr[0]), __uint_as_float(rr[1]));
}
__device__ __forceinline__ float xhalf_sum(float m) {
    auto rr = __builtin_amdgcn_permlane32_swap(__float_as_uint(m), __float_as_uint(m), false, false);
    return __uint_as_float(rr[0]) + __uint_as_float(rr[1]);
}
struct St { float m, l; f32x16 o0, o1; };
__device__ __forceinline__ void st_init(St& S) {
    S.m = 0.f; S.l = 0.f;
#pragma unroll
    for (int r = 0; r < 16; ++r) { S.o0[r] = 0.f; S.o1[r] = 0.f; }
}

template <int MODE>
__device__ __forceinline__ void step(St& S, const bf16x8 (&qf)[4], int kb, int qpos0, bool diag, bool first, float cq, float cfar, const LAS float* tab,
                                     const LAS unsigned char* kimg, unsigned vaddr, int r32, int hi) {
    bf16x8 kf[4];
#pragma unroll
    for (int d0 = 0; d0 < 4; ++d0) kf[d0] = *(const LAS bf16x8*)(kimg + r32 * 128 + (((d0 * 2 + hi) ^ ((r32 >> 1) & 7)) << 4));
    f32x16 s;
    if (MODE == 1) {
        const float nm = cq - S.m;
#pragma unroll
        for (int g = 0; g < 4; ++g) { const f32x4 ck = *(const LAS f32x4*)(tab + kb * 32 + 8 * g + 4 * hi);
#pragma unroll
            for (int e = 0; e < 4; ++e) s[4 * g + e] = nm - ck[e]; }
    } else {
        if (qpos0 - (kb * 32 + 31) >= 128) {
            const float c = cfar - S.m;
#pragma unroll
            for (int r = 0; r < 16; ++r) s[r] = c;
        } else {
            const int dd = qpos0 + r32 - kb * 32 + 128;
#pragma unroll
            for (int r = 0; r < 16; ++r) { int idx = dd - crow(r, hi); idx = idx < 0 ? 0 : (idx > 256 ? 256 : idx); s[r] = tab[idx] - S.m; }
        }
    }
#pragma unroll
    for (int d0 = 0; d0 < 4; ++d0) s = __builtin_amdgcn_mfma_f32_32x32x16_bf16(kf[d0], qf[d0], s, 0, 0, 0);
    if (MODE == 1 && diag) {
#pragma unroll
        for (int r = 0; r < 16; ++r) if (crow(r, hi) > r32) s[r] = -1e30f;
    }
    float rm = fmaxf(fmaxf(s[0], s[1]), fmaxf(s[2], s[3]));
#pragma unroll
    for (int r = 4; r < 16; r += 4) rm = fmaxf(rm, fmaxf(fmaxf(s[r], s[r + 1]), fmaxf(s[r + 2], s[r + 3])));
    rm = xhalf_max(rm);
    if (first || __any(rm > THR)) {
        const float dl = first ? rm : fmaxf(rm, 0.f); S.m += dl;
        const float f = first ? 1.0f : __builtin_amdgcn_exp2f(-dl); S.l *= f;
#pragma unroll
        for (int r = 0; r < 16; ++r) { s[r] -= dl; S.o0[r] *= f; S.o1[r] *= f; }
    }
    float ls = 0.f;
#pragma unroll
    for (int r = 0; r < 16; ++r) { s[r] = __builtin_amdgcn_exp2f(s[r]); ls += s[r]; }
    S.l += ls;
    u32x4 pw0, pw1;
    pw0.x = pk2(s[0], s[1]); pw0.y = pk2(s[2], s[3]); pw0.z = pk2(s[4], s[5]); pw0.w = pk2(s[6], s[7]);
    pw1.x = pk2(s[8], s[9]); pw1.y = pk2(s[10], s[11]); pw1.z = pk2(s[12], s[13]); pw1.w = pk2(s[14], s[15]);
    const bf16x8 pf0 = __builtin_bit_cast(bf16x8, pw0), pf1 = __builtin_bit_cast(bf16x8, pw1);
    s16x4 vlo[4], vhi[4];
#define ATT_TR(dst, off) asm volatile("ds_read_b64_tr_b16 %0, %1 offset:%c2" : "=&v"(dst) : "v"(vaddr), "i"(off) : "memory")
    ATT_TR(vlo[0], 0);    ATT_TR(vhi[0], 1024);
    ATT_TR(vlo[1], 2048); ATT_TR(vhi[1], 3072);
    ATT_TR(vlo[2], 512);  ATT_TR(vhi[2], 1536);
    ATT_TR(vlo[3], 2560); ATT_TR(vhi[3], 3584);
#undef ATT_TR
    asm volatile("s_waitcnt lgkmcnt(0)" ::: "memory");
    __builtin_amdgcn_sched_barrier(0);
#define ATT_VF(i) (bf16x8){vlo[i][0], vlo[i][1], vlo[i][2], vlo[i][3], vhi[i][0], vhi[i][1], vhi[i][2], vhi[i][3]}
    S.o0 = __builtin_amdgcn_mfma_f32_32x32x16_bf16(ATT_VF(0), pf0, S.o0, 0, 0, 0);
    S.o0 = __builtin_amdgcn_mfma_f32_32x32x16_bf16(ATT_VF(1), pf1, S.o0, 0, 0, 0);
    S.o1 = __builtin_amdgcn_mfma_f32_32x32x16_bf16(ATT_VF(2), pf0, S.o1, 0, 0, 0);
    S.o1 = __builtin_amdgcn_mfma_f32_32x32x16_bf16(ATT_VF(3), pf1, S.o1, 0, 0, 0);
#undef ATT_VF
}
__device__ __forceinline__ float max3f(float a, float b, float c) { float r; asm("v_max3_f32 %0, %1, %2, %3" : "=v"(r) : "v"(a), "v"(b), "v"(c)); return r; }
template <int MODE>
__device__ __forceinline__ void step64(St& S, const bf16x8 (&qf)[4], int t, int qpos0, bool diag, bool first, float cq, float cfar, const LAS float* tab,
                                       const LAS unsigned char* buf, unsigned vaddr, int r32, int hi) {
    bf16x8 ka[4], kc[4];
#pragma unroll
    for (int d0 = 0; d0 < 4; ++d0) { const int o = r32 * 128 + (((d0 * 2 + hi) ^ ((r32 >> 1) & 7)) << 4); ka[d0] = *(const LAS bf16x8*)(buf + o); kc[d0] = *(const LAS bf16x8*)(buf + 4096 + o); }
    f32x16 sa, sb;
    if (MODE == 1) {
        const float nm = cq - S.m;
#pragma unroll
        for (int g = 0; g < 4; ++g) { const f32x4 c0 = *(const LAS f32x4*)(tab + t * 64 + 8 * g + 4 * hi), c1 = *(const LAS f32x4*)(tab + t * 64 + 32 + 8 * g + 4 * hi);
#pragma unroll
            for (int e = 0; e < 4; ++e) { sa[4 * g + e] = nm - c0[e]; sb[4 * g + e] = nm - c1[e]; } }
    } else {
        if (qpos0 - (t * 64 + 31) >= 128) {
            const float c = cfar - S.m;
#pragma unroll
            for (int r = 0; r < 16; ++r) sa[r] = c;
        } else {
            const int dd = qpos0 + r32 - t * 64 + 128;
#pragma unroll
            for (int r = 0; r < 16; ++r) { int idx = dd - crow(r, hi); idx = idx < 0 ? 0 : (idx > 256 ? 256 : idx); sa[r] = tab[idx] - S.m; }
        }
        if (qpos0 - (t * 64 + 63) >= 128) {
            const float c = cfar - S.m;
#pragma unroll
            for (int r = 0; r < 16; ++r) sb[r] = c;
        } else {
            const int dd = qpos0 + r32 - t * 64 - 32 + 128;
#pragma unroll
            for (int r = 0; r < 16; ++r) { int idx = dd - crow(r, hi); idx = idx < 0 ? 0 : (idx > 256 ? 256 : idx); sb[r] = tab[idx] - S.m; }
        }
    }
#pragma unroll
    for (int d0 = 0; d0 < 4; ++d0) { sa = __builtin_amdgcn_mfma_f32_32x32x16_bf16(ka[d0], qf[d0], sa, 0, 0, 0); sb = __builtin_amdgcn_mfma_f32_32x32x16_bf16(kc[d0], qf[d0], sb, 0, 0, 0); }
    s16x4 vlo[8], vhi[8];
#define ATT_TR(dst, off) asm volatile("ds_read_b64_tr_b16 %0, %1 offset:%c2" : "=&v"(dst) : "v"(vaddr), "i"(off) : "memory")
    ATT_TR(vlo[0], 0);           ATT_TR(vhi[0], 1024);          ATT_TR(vlo[1], 2048);        ATT_TR(vhi[1], 3072);
    ATT_TR(vlo[2], 512);         ATT_TR(vhi[2], 1536);          ATT_TR(vlo[3], 2560);        ATT_TR(vhi[3], 3584);
    ATT_TR(vlo[4], 4096 + 0);    ATT_TR(vhi[4], 4096 + 1024);   ATT_TR(vlo[5], 4096 + 2048); ATT_TR(vhi[5], 4096 + 3072);
    ATT_TR(vlo[6], 4096 + 512);  ATT_TR(vhi[6], 4096 + 1536);   ATT_TR(vlo[7], 4096 + 2560); ATT_TR(vhi[7], 4096 + 3584);
#undef ATT_TR
    if (MODE == 1 && diag) {
        const int qrel = qpos0 - t * 64 + r32;
#pragma unroll
        for (int r = 0; r < 16; ++r) { if (crow(r, hi) > qrel) sa[r] = -1e30f; if (crow(r, hi) + 32 > qrel) sb[r] = -1e30f; }
    }
    float r0 = max3f(sa[0], sa[1], sa[2]), r1 = max3f(sb[0], sb[1], sb[2]);
#pragma unroll
    for (int r = 3; r < 15; r += 2) { r0 = max3f(r0, sa[r], sa[r + 1]); r1 = max3f(r1, sb[r], sb[r + 1]); }
    float rm = max3f(r0, r1, fmaxf(sa[15], sb[15]));
    rm = xhalf_max(rm);
    if (first || __any(rm > THR)) {
        const float dl = first ? rm : fmaxf(rm, 0.f); S.m += dl;
        const float f = first ? 1.0f : __builtin_amdgcn_exp2f(-dl); S.l *= f;
#pragma unroll
        for (int r = 0; r < 16; ++r) { sa[r] -= dl; sb[r] -= dl; S.o0[r] *= f; S.o1[r] *= f; }
    }
    float l0 = 0.f, l1 = 0.f, l2 = 0.f, l3 = 0.f;
#pragma unroll
    for (int r = 0; r < 16; r += 2) { sa[r] = __builtin_amdgcn_exp2f(sa[r]); sa[r + 1] = __builtin_amdgcn_exp2f(sa[r + 1]); sb[r] = __builtin_amdgcn_exp2f(sb[r]); sb[r + 1] = __builtin_amdgcn_exp2f(sb[r + 1]);
        l0 += sa[r]; l1 += sa[r + 1]; l2 += sb[r]; l3 += sb[r + 1]; }
    S.l += (l0 + l1) + (l2 + l3);
    u32x4 pa0, pa1, pb0, pb1;
    pa0.x = pk2(sa[0], sa[1]); pa0.y = pk2(sa[2], sa[3]); pa0.z = pk2(sa[4], sa[5]); pa0.w = pk2(sa[6], sa[7]);
    pa1.x = pk2(sa[8], sa[9]); pa1.y = pk2(sa[10], sa[11]); pa1.z = pk2(sa[12], sa[13]); pa1.w = pk2(sa[14], sa[15]);
    pb0.x = pk2(sb[0], sb[1]); pb0.y = pk2(sb[2], sb[3]); pb0.z = pk2(sb[4], sb[5]); pb0.w = pk2(sb[6], sb[7]);
    pb1.x = pk2(sb[8], sb[9]); pb1.y = pk2(sb[10], sb[11]); pb1.z = pk2(sb[12], sb[13]); pb1.w = pk2(sb[14], sb[15]);
    asm volatile("s_waitcnt lgkmcnt(0)" ::: "memory");
    __builtin_amdgcn_sched_barrier(0);
#define ATT_VF(i) (bf16x8){vlo[i][0], vlo[i][1], vlo[i][2], vlo[i][3], vhi[i][0], vhi[i][1], vhi[i][2], vhi[i][3]}
#define ATT_PF(x) __builtin_bit_cast(bf16x8, x)
    S.o0 = __builtin_amdgcn_mfma_f32_32x32x16_bf16(ATT_VF(0), ATT_PF(pa0), S.o0, 0, 0, 0);
    S.o1 = __builtin_amdgcn_mfma_f32_32x32x16_bf16(ATT_VF(2), ATT_PF(pa0), S.o1, 0, 0, 0);
    S.o0 = __builtin_amdgcn_mfma_f32_32x32x16_bf16(ATT_VF(1), ATT_PF(pa1), S.o0, 0, 0, 0);
    S.o1 = __builtin_amdgcn_mfma_f32_32x32x16_bf16(ATT_VF(3), ATT_PF(pa1), S.o1, 0, 0, 0);
    S.o0 = __builtin_amdgcn_mfma_f32_32x32x16_bf16(ATT_VF(4), ATT_PF(pb0), S.o0, 0, 0, 0);
    S.o1 = __builtin_amdgcn_mfma_f32_32x32x16_bf16(ATT_VF(6), ATT_PF(pb0), S.o1, 0, 0, 0);
    S.o0 = __builtin_amdgcn_mfma_f32_32x32x16_bf16(ATT_VF(5), ATT_PF(pb1), S.o0, 0, 0, 0);
    S.o1 = __builtin_amdgcn_mfma_f32_32x32x16_bf16(ATT_VF(7), ATT_PF(pb1), S.o1, 0, 0, 0);
#undef ATT_VF
#undef ATT_PF
}
__device__ __forceinline__ unsigned v_lane_off(int lane) { return (unsigned)((4 * (lane >> 5) + ((lane & 15) >> 2)) * 64 + ((lane >> 4) & 1) * 32 + (lane & 3) * 8); }

__device__ __forceinline__ void finish(St& S, bf16_t* Yrow, const bf16_t* __restrict__ Grow, int r32, int hi) {
    const float inv = 1.0f / xhalf_sum(S.l);
#pragma unroll
    for (int db = 0; db < 2; ++db)
#pragma unroll
        for (int g = 0; g < 4; ++g) {
            const int d = 32 * db + 8 * g + 4 * hi;
            const u32x2 gw2 = *(const u32x2*)(Grow + r32 * 64 + d);
            const float a0 = (db ? S.o1[4 * g + 0] : S.o0[4 * g + 0]) * inv * bf_lo(gw2.x), a1 = (db ? S.o1[4 * g + 1] : S.o0[4 * g + 1]) * inv * bf_hi(gw2.x);
            const float a2 = (db ? S.o1[4 * g + 2] : S.o0[4 * g + 2]) * inv * bf_lo(gw2.y), a3 = (db ? S.o1[4 * g + 3] : S.o0[4 * g + 3]) * inv * bf_hi(gw2.y);
            u32x2 w; w.x = pk2(a0, a1); w.y = pk2(a2, a3);
            *(u32x2*)(Yrow + (size_t)r32 * 1024 + d) = w;
        }
}

template <int MODE>
__device__ __forceinline__ void super_unit(const bf16_t* __restrict__ Qrow, const bf16_t* __restrict__ Kb, const bf16_t* __restrict__ Vb, int T0, int T1, int t_lo, int t_hi, int qpos0,
                                           const LAS float* tab, bf16_t* Yrow, const bf16_t* __restrict__ Grow, LAS unsigned char* ring, int tid, int lane) {
    asm volatile("" : "+v"(tid)); lane = tid & 63;
    const int r32 = lane & 31, hi = lane >> 5;
    bf16x8 qf[4];
#pragma unroll
    for (int d0 = 0; d0 < 4; ++d0) qf[d0] = *(const bf16x8*)(Qrow + r32 * 64 + d0 * 16 + hi * 8);
    const int key = tid >> 3, ch = tid & 7, sub = key >> 5, k32 = key & 31;
    const int koff = sub * 4096 + k32 * 128 + ((ch ^ ((k32 >> 1) & 7)) << 4);
    const int voff = 8192 + sub * 4096 + (k32 >> 3) * 1024 + (ch >> 2) * 512 + (k32 & 7) * 64 + (ch & 3) * 16;
    const bf16_t* kg = Kb + tid * 8;
    const bf16_t* vg = Vb + tid * 8;
    u32x4 ka = *(const u32x4*)(kg + (size_t)T0 * 4096), va = *(const u32x4*)(vg + (size_t)T0 * 4096), kb2 = ka, vb2 = va;
    if (T0 + 1 < T1) { kb2 = *(const u32x4*)(kg + (size_t)(T0 + 1) * 4096); vb2 = *(const u32x4*)(vg + (size_t)(T0 + 1) * 4096); }
    *(LAS u32x4*)(ring + (T0 & 1) * 16384 + koff) = ka; *(LAS u32x4*)(ring + (T0 & 1) * 16384 + voff) = va;
    const float cq = (MODE == 1) ? tab[qpos0 + r32] : 0.f;
    const float cfar = (MODE == 0) ? tab[256] : 0.f;
    const unsigned vl = v_lane_off(lane);
    St S; st_init(S);
    asm volatile("" :: "v"(qf[0]), "v"(qf[1]), "v"(qf[2]), "v"(qf[3]));
    __syncthreads();
    for (int t = T0; t < T1; t += 2) {
        {
            if (t + 2 < T1) { ka = *(const u32x4*)(kg + (size_t)(t + 2) * 4096); va = *(const u32x4*)(vg + (size_t)(t + 2) * 4096); }
            LAS unsigned char* buf = ring + (t & 1) * 16384;
            if (t >= t_lo && t < t_hi)
                step64<MODE>(S, qf, t, qpos0, t == t_hi - 1, t == t_lo, cq, cfar, tab, buf, (unsigned)(unsigned long)(buf + 8192) + vl, r32, hi);
            if (t + 1 < T1) { LAS unsigned char* nb = ring + ((t + 1) & 1) * 16384; *(LAS u32x4*)(nb + koff) = kb2; *(LAS u32x4*)(nb + voff) = vb2; }
            __syncthreads();
        }
        if (t + 1 < T1) {
            const int t1 = t + 1;
            if (t1 + 2 < T1) { kb2 = *(const u32x4*)(kg + (size_t)(t1 + 2) * 4096); vb2 = *(const u32x4*)(vg + (size_t)(t1 + 2) * 4096); }
            LAS unsigned char* buf = ring + (t1 & 1) * 16384;
            if (t1 >= t_lo && t1 < t_hi)
                step64<MODE>(S, qf, t1, qpos0, t1 == t_hi - 1, t1 == t_lo, cq, cfar, tab, buf, (unsigned)(unsigned long)(buf + 8192) + vl, r32, hi);
            if (t1 + 1 < T1) { LAS unsigned char* nb = ring + ((t1 + 1) & 1) * 16384; *(LAS u32x4*)(nb + koff) = ka; *(LAS u32x4*)(nb + voff) = va; }
            __syncthreads();
        }
    }
    finish(S, Yrow, Grow, r32, hi);
}

template <int MODE>
__device__ __forceinline__ void split_unit(const bf16_t* __restrict__ Qrow, const bf16_t* __restrict__ Kb, const bf16_t* __restrict__ Vb, int kb0, int kb1, int kdiag, int qpos0,
                                           const LAS float* tab, bf16_t* Yrow, const bf16_t* __restrict__ Grow, LAS unsigned char* stage0, int wave, int lane) {
    asm volatile("" : "+v"(lane));
    const int r32 = lane & 31, hi = lane >> 5;
    LAS unsigned char* st = stage0 + wave * 8704;
    bf16x8 qf[4];
#pragma unroll
    for (int d0 = 0; d0 < 4; ++d0) qf[d0] = *(const bf16x8*)(Qrow + r32 * 64 + d0 * 16 + hi * 8);
    const int skey = lane >> 3, sch = lane & 7;
    const int kwA = skey * 128 + ((sch ^ (skey >> 1)) << 4), kwB = skey * 128 + ((sch ^ ((skey >> 1) + 4)) << 4);
    const int vw0 = 4096 + (sch >> 2) * 512 + skey * 64 + (sch & 3) * 16;
    const bf16_t* kg = Kb + lane * 8;
    const bf16_t* vg = Vb + lane * 8;
    const unsigned vaddr = (unsigned)(unsigned long)(st + 4096) + v_lane_off(lane);
    u32x4 kr[4], vr[4];
#pragma unroll
    for (int i = 0; i < 4; ++i) { kr[i] = *(const u32x4*)(kg + (size_t)(kb0 * 32 + 8 * i) * 64); vr[i] = *(const u32x4*)(vg + (size_t)(kb0 * 32 + 8 * i) * 64); }
    const float cq = (MODE == 1) ? tab[qpos0 + r32] : 0.f;
    const float cfar = (MODE == 0) ? tab[256] : 0.f;
    St S; st_init(S);
    asm volatile("" :: "v"(qf[0]), "v"(qf[1]), "v"(qf[2]), "v"(qf[3]));
    for (int kb = kb0; kb < kb1; ++kb) {
#pragma unroll
        for (int i = 0; i < 4; ++i) { *(LAS u32x4*)(st + ((i & 1) ? kwB : kwA) + i * 1024) = kr[i]; *(LAS u32x4*)(st + vw0 + i * 1024) = vr[i]; }
        if (kb + 1 < kb1) {
#pragma unroll
            for (int i = 0; i < 4; ++i) { kr[i] = *(const u32x4*)(kg + (size_t)((kb + 1) * 32 + 8 * i) * 64); vr[i] = *(const u32x4*)(vg + (size_t)((kb + 1) * 32 + 8 * i) * 64); }
        }
        step<MODE>(S, qf, kb, qpos0, kb == kdiag, kb == kb0, cq, cfar, tab, st, vaddr, r32, hi);
    }
    LAS float* part = (LAS float*)st;
    const float lt = xhalf_sum(S.l);
    part[0 * 64 + lane] = S.m; part[1 * 64 + lane] = lt;
#pragma unroll
    for (int r = 0; r < 16; ++r) { part[(2 + r) * 64 + lane] = S.o0[r]; part[(18 + r) * 64 + lane] = S.o1[r]; }
    __syncthreads();
    {
        const int db = wave & 1, g = wave >> 1;
        float mw[8]; float M = -3.0e38f;
#pragma unroll
        for (int w = 0; w < 8; ++w) { mw[w] = ((const LAS float*)(stage0 + w * 8704))[lane]; M = fmaxf(M, mw[w]); }
        float L = 0.f, a0 = 0.f, a1 = 0.f, a2 = 0.f, a3 = 0.f;
#pragma unroll
        for (int w = 0; w < 8; ++w) {
            const LAS float* pw = (const LAS float*)(stage0 + w * 8704);
            const float sc = __builtin_amdgcn_exp2f(mw[w] - M);
            L += sc * pw[64 + lane];
            const int base = (2 + 16 * db + 4 * g) * 64 + lane;
            a0 += sc * pw[base]; a1 += sc * pw[base + 64]; a2 += sc * pw[base + 128]; a3 += sc * pw[base + 192];
        }
        const float inv = 1.0f / L;
        const int d = 32 * db + 8 * g + 4 * hi;
        const u32x2 gw2 = *(const u32x2*)(Grow + r32 * 64 + d);
        u32x2 wv; wv.x = pk2(a0 * inv * bf_lo(gw2.x), a1 * inv * bf_hi(gw2.x)); wv.y = pk2(a2 * inv * bf_lo(gw2.y), a3 * inv * bf_hi(gw2.y));
        *(u32x2*)(Yrow + (size_t)r32 * 1024 + d) = wv;
    }
    __syncthreads();
}
}

__device__ __forceinline__ void phase2(const Params& P, LAS unsigned char* lds, int tid, int lane, int wave) {
    LAS float* c2p = (LAS float*)(lds);
    LAS float* c2s = (LAS float*)(lds + 8192);
    LAS float* rb2 = (LAS float*)(lds + 8192 + 8448);
    LAS unsigned char* work = lds + 18432;
    for (int vb = blockIdx.x; vb < 256; vb += gridDim.x) {
        const int b = vb >> 3, h = vb & 7;
        __syncthreads();
        {
            const float* C2P = (const float*)(P.ws + WS_C2P); const float* C2S = (const float*)(P.ws + WS_C2S);
            for (int i = tid; i < 2048; i += 512) c2p[i] = C2P[(size_t)vb * 2048 + i];
            if (vb < 64) for (int i = tid; i < LBS_LEN; i += 512) c2s[i] = C2S[(size_t)vb * LBS_LEN + i];
            for (int i = tid; i < NREL; i += 512) rb2[i] = P.relb[h * NREL + i] * LOG2E;
        }
        __syncthreads();
        if (vb < 128) {
            const int mode = vb < 64, bs = (vb & 63) >> 3;
            const size_t qrow = (size_t)MP + bs * NST;
            const int L = mode ? LBS_LEN : LAS_LEN, nb = L / 32;
            const size_t kvo = (size_t)(bs * 8 + h) * L * 64;
            const size_t qgo = ((size_t)(32 * 8 + h) * 2048 + bs * NST) * 64;
            const int kb0 = (wave * nb) >> 3, kb1 = ((wave + 1) * nb) >> 3;
            const bf16_t* Qrow = (const bf16_t*)(P.ws + WS_SEG + (size_t)(mode ? 4 : 0) * SEG_STRIDE) + qgo;
            const bf16_t* Grow = (const bf16_t*)(P.ws + WS_SEG + (size_t)(mode ? 7 : 3) * SEG_STRIDE) + qgo;
            bf16_t* Yrow = (bf16_t*)(P.ws + WS_H) + qrow * 1024 + (mode ? 512 : 0) + h * 64;
            if (mode) att::split_unit<1>(Qrow, (const bf16_t*)(P.ws + WS_KBS) + kvo, (const bf16_t*)(P.ws + WS_VBS) + kvo, kb0, kb1, nb - 1, PAST, c2s, Yrow, Grow, work, wave, lane);
            else      att::split_unit<0>(Qrow, (const bf16_t*)(P.ws + WS_KAS) + kvo, (const bf16_t*)(P.ws + WS_VAS) + kvo, kb0, kb1, -1, LAC, rb2, Yrow, Grow, work, wave, lane);
        }
        for (int it = 0; it < 16; ++it) {
            const int mode = it < 8, u = it & 7;
            const int hc = 8 * u + wave;
            const size_t qrow = (size_t)b * SEQ + hc * 32;
            const size_t ho = (size_t)(b * 8 + h) * 2048 * 64;
            const bf16_t* Qrow = (const bf16_t*)(P.ws + WS_SEG + (size_t)(mode ? 4 : 0) * SEG_STRIDE) + ho + (size_t)hc * 32 * 64;
            const bf16_t* Grow = (const bf16_t*)(P.ws + WS_SEG + (size_t)(mode ? 7 : 3) * SEG_STRIDE) + ho + (size_t)hc * 32 * 64;
            const bf16_t* Kb = (const bf16_t*)(P.ws + WS_SEG + (size_t)(mode ? 5 : 1) * SEG_STRIDE) + ho;
            const bf16_t* Vb = (const bf16_t*)(P.ws + WS_SEG + (size_t)(mode ? 6 : 2) * SEG_STRIDE) + ho;
            bf16_t* Yrow = (bf16_t*)(P.ws + WS_H) + qrow * 1024 + (mode ? 512 : 0) + h * 64;
            if (mode) {
                att::super_unit<1>(Qrow, Kb, Vb, 0, 4 * u + 4, 0, (hc >> 1) + 1, hc * 32, c2p, Yrow, Grow, work, tid, lane);
            } else {
                const int n = hc >> 1, lo = (n - 8) < 0 ? 0 : (n - 8), t0 = (4 * u - 8) < 0 ? 0 : (4 * u - 8);
                att::super_unit<0>(Qrow, Kb, Vb, t0, 4 * u + 4, lo, n + 1, hc * 32, rb2, Yrow, Grow, work, tid, lane);
            }
        }
    }
}

__device__ __forceinline__ void phase4(const Params& P, int lane, int wave) {
    const int gw = blockIdx.x * 8 + wave, NGW = gridDim.x * 8;
    const bf16_t* mo = (const bf16_t*)(P.ws + WS_SEG);
    f32x4 g4[4];
#pragma unroll
    for (int j = 0; j < 4; ++j) g4[j] = *(const f32x4*)(P.fgain + 4 * lane + 256 * j);
    f32x4 v[4]; u32x2 mv[4];
    int m = gw;
    if (m < MT) {
        const float* xrow = (m < MP) ? P.xp + (size_t)m * 1024 : P.xs + (size_t)(m - MP) * 1024;
#pragma unroll
        for (int j = 0; j < 4; ++j) { v[j] = *(const f32x4*)(xrow + 4 * lane + 256 * j); mv[j] = *(const u32x2*)(mo + (size_t)m * 1024 + 4 * lane + 256 * j); }
    }
    for (; m < MT; m += NGW) {
        f32x4 r[4]; float ss = 0.f;
#pragma unroll
        for (int j = 0; j < 4; ++j) {
            r[j][0] = v[j][0] + bf_lo(mv[j].x); r[j][1] = v[j][1] + bf_hi(mv[j].x); r[j][2] = v[j][2] + bf_lo(mv[j].y); r[j][3] = v[j][3] + bf_hi(mv[j].y);
            ss += (r[j][0] * r[j][0] + r[j][1] * r[j][1]) + (r[j][2] * r[j][2] + r[j][3] * r[j][3]);
        }
        const int mn = m + NGW;
        if (mn < MT) {
            const float* xrow = (mn < MP) ? P.xp + (size_t)mn * 1024 : P.xs + (size_t)(mn - MP) * 1024;
#pragma unroll
            for (int j = 0; j < 4; ++j) { v[j] = *(const f32x4*)(xrow + 4 * lane + 256 * j); mv[j] = *(const u32x2*)(mo + (size_t)mn * 1024 + 4 * lane + 256 * j); }
        }
        ss = wave_sum(ss);
        const float rstd = 1.0f / sqrtf(ss * (1.0f / 1024.0f) + RMS_EPS);
        float* row = P.out + (size_t)m * 1024;
#pragma unroll
        for (int j = 0; j < 4; ++j) *(f32x4*)(row + 4 * lane + 256 * j) = r[j] * rstd * g4[j];
    }
}

#define LOAD_PARAMS() const Params& P = Parg
__device__ __forceinline__ int my_tid() { int t = (int)threadIdx.x; asm volatile("" : "+v"(t)); return t; }
#define MY_TID() my_tid()
__global__ void __launch_bounds__(512, 2) hymba_fwd(Params Parg) {
    extern __shared__ __attribute__((aligned(16))) unsigned char lds_raw[];
    LAS unsigned char* lds = (LAS unsigned char*)lds_raw;
    cg::grid_group grid = cg::this_grid();
    const int wave = __builtin_amdgcn_readfirstlane((int)threadIdx.x >> 6);

    {   LOAD_PARAMS(); const int tid = MY_TID();
        phase0(P, lds, tid, tid & 63, wave); }
    grid.sync();

    {
        LOAD_PARAMS(); const int tid = MY_TID();
        LAS float* red = (LAS float*)(lds);
        for (int u = blockIdx.x; u < 256; u += gridDim.x) {
            const int b = u >> 3, h = u & 7;
            const float* src = P.out + O_LFP + ((size_t)b * SEQ) * 8 + h;
            block_cumsum<4>(SEQ, [&](int t) { return src[(size_t)t * 8]; }, (float*)(P.ws + WS_C2P) + (size_t)u * 2048, red, tid);
        }
        for (int u = blockIdx.x; u < 64; u += gridDim.x) {
            const int b = u >> 3, h = u & 7;
            const float* src0 = P.cblf + ((size_t)b * PAST) * 8 + h;
            const float* src1 = P.out + O_LFS + ((size_t)b * NST) * 8 + h;
            block_cumsum<5>(LBS_LEN, [&](int t) { return t < PAST ? src0[(size_t)t * 8] : src1[(size_t)(t - PAST) * 8]; }, (float*)(P.ws + WS_C2S) + (size_t)u * LBS_LEN, red, tid);
        }
        pg8::Gemm g{(const bf16_t*)(P.ws + WS_H), (const bf16_t*)(P.ws + WS_WIN), MT, 4096, 1024};
        pg8::StaticOrder S; S.init(MT, 4096, (int)gridDim.x, (int)blockIdx.x);
        EpiProj E{P.ws, P.out};
        pg8::gemm_phase<EpiProj, pg8::StaticOrder, true, true>(lds, g, S, E, tid);
    }
    grid.sync();

    {   LOAD_PARAMS(); const int tid = MY_TID();
        phase2(P, lds, tid, tid & 63, wave); }
    grid.sync();

    {
        LOAD_PARAMS(); const int tid = MY_TID();
        pg8::Gemm g{(const bf16_t*)(P.ws + WS_H), (const bf16_t*)(P.ws + WS_WOUT), MT, 1024, 1024};
        pg8::StaticOrder S; S.init(MT, 1024, (int)gridDim.x, (int)blockIdx.x);
        EpiOut E{(bf16_t*)(P.ws + WS_SEG)};
        pg8::gemm_phase<EpiOut, pg8::StaticOrder, true, true>(lds, g, S, E, tid);
    }
    grid.sync();

    {   LOAD_PARAMS(); const int tid = MY_TID();
        phase4(P, (int)__builtin_amdgcn_mbcnt_hi(~0u, __builtin_amdgcn_mbcnt_lo(~0u, 0u)), wave); }
}

extern "C" void kernel_launch(void* const* d_in, const int* in_sizes, int n_in, void* d_out, int out_size, void* d_ws, size_t ws_size, hipStream_t stream) {
    static int grid = 0;
    if (grid == 0) {
        if (n_in != 13 || in_sizes[0] != MP * 1024 || (size_t)out_size != O_END || ws_size < WS_END) {
            fprintf(stderr, "kernel_launch: shape mismatch: n_in %d in0 %d out %d (want %zu) ws %zu (want %zu)\n", n_in, n_in > 0 ? in_sizes[0] : -1, out_size, (size_t)O_END, ws_size, (size_t)WS_END);
            grid = -1; return;
        }
        int dev = 0, cus = 0, per_cu = 0;
        hipGetDevice(&dev);
        hipDeviceGetAttribute(&cus, hipDeviceAttributeMultiprocessorCount, dev);
        hipFuncSetAttribute((const void*)hymba_fwd, hipFuncAttributeMaxDynamicSharedMemorySize, LDS_BYTES);
        hipOccupancyMaxActiveBlocksPerMultiprocessor(&per_cu, (const void*)hymba_fwd, 512, LDS_BYTES);
        if (per_cu < 1 || cus < 1) { fprintf(stderr, "kernel_launch: occupancy query gave %d blocks/CU on %d CUs\n", per_cu, cus); grid = -1; return; }
        grid = cus * per_cu;
        if (grid > 256) grid = 256;
    }
    if (grid < 0) return;
    Params p{};
    p.xp = (const float*)d_in[0]; p.xs = (const float*)d_in[1]; p.cak = (const float*)d_in[2]; p.cav = (const float*)d_in[3]; p.cbk = (const float*)d_in[4]; p.cbv = (const float*)d_in[5];
    p.cblf = (const float*)d_in[6]; p.gain = (const float*)d_in[7]; p.win = (const float*)d_in[8]; p.bfg = (const float*)d_in[9]; p.relb = (const float*)d_in[10]; p.wout = (const float*)d_in[11];
    p.fgain = (const float*)d_in[12]; p.out = (float*)d_out; p.ws = (unsigned char*)d_ws;
    void* args[] = {&p};
    hipError_t e = hipLaunchCooperativeKernel((const void*)hymba_fwd, dim3(grid), dim3(512), args, LDS_BYTES, stream);
    if (e != hipSuccess) fprintf(stderr, "cooperative launch failed: %s (grid %d)\n", hipGetErrorString(e), grid);
}
```

```cpp
#include <hip/hip_runtime.h>
#include <hip/hip_cooperative_groups.h>
#include <cstdio>
#include <cstdint>
namespace cg = cooperative_groups;
namespace pg8 {
#define PG8_LAS __attribute__((address_space(3)))
typedef unsigned short bf16_t;
typedef short bf16x8 __attribute__((ext_vector_type(8)));
typedef float f32x4 __attribute__((ext_vector_type(4)));
typedef unsigned u32x4 __attribute__((ext_vector_type(4)));
constexpr int BM = 256, BK = 64, HALF = 128, HTB = HALF * BK * 2  , STAGE_BYTES = 8 * HTB, NXCD = 8, WGM = 8;

__host__ __device__ __forceinline__ int lds_byte(int r, int c) { const int st = (r >> 4) * 2 + (c >> 5), rr = r & 15, cc = c & 31, ob = rr * 64 + cc * 2; return st * 1024 + (ob ^ (((ob >> 9) & 1) << 5)); }
__host__ __device__ __forceinline__ void stage_rc(int b, int& R, int& C) { const int st = b / 1024, sb = b % 1024, swz = sb ^ (((sb >> 9) & 1) << 5); R = (st >> 1) * 16 + swz / 64; C = (st & 1) * 32 + (swz % 64) / 2; }
__host__ __device__ __forceinline__ int perm32(int rho) { const int n = rho >> 4, i = rho & 15; return 8 * (i >> 2) + 4 * n + (i & 3); }

struct Unit { int pm, pn; };
struct Gemm { const bf16_t* A; const bf16_t* Bt; int M, N, K; };

struct StaticOrder {
    int nM, nN, nwg, G, c;
    __host__ __device__ void init(int M, int N, int G_, int c_) { nM = M / BM; nN = N / BM; nwg = nM * nN; G = G_; c = c_; }
    __host__ __device__ bool next(int i, Unit& u) const {
        const long L = (long)i * G + c; if (L >= nwg) return false;
        int wgid = (int)L; { const int q = nwg / NXCD, r = nwg % NXCD, xcd = wgid % NXCD, off = wgid / NXCD; wgid = (xcd < r ? xcd * (q + 1) : r * (q + 1) + (xcd - r) * q) + off; }
        const int nig = WGM * nN, gid = wgid / nig, fm = gid * WGM, gsz = (nM - fm) < WGM ? (nM - fm) : WGM;
        u.pm = fm + ((wgid % nig) % gsz); u.pn = (wgid % nig) / gsz; return true;
    }
    __device__ __forceinline__ void a_ready(const Unit&) const {}
    __device__ __forceinline__ void done(const Unit&) const {}
};
__device__ __forceinline__ unsigned cvt_pk_bf16(float lo, float hi) { unsigned r; asm volatile("v_cvt_pk_bf16_f32 %0, %1, %2" : "=v"(r) : "v"(lo), "v"(hi)); return r; }
typedef float f32x2 __attribute__((ext_vector_type(2)));
template <class Epi, class Sched, bool ALIGN_EPI = false, bool SP2 = false>
__device__ __forceinline__ void gemm_phase(PG8_LAS unsigned char* lds, const Gemm g, const Sched& S, const Epi& E, const int tid) {
    const int wid = __builtin_amdgcn_readfirstlane(tid >> 6), lane = tid & 63, wr = wid >> 2, wc = wid & 3, fr = lane & 15, fq = lane >> 4;
    const int K = g.K, nt = K / BK;
    unsigned voffA[2], voffB[2];
#pragma unroll
    for (int i = 0; i < 2; ++i) { int R, C; stage_rc(tid * 16 + i * 8192, R, C); const int Rb = Epi::PERM ? ((R & ~31) + perm32(R & 31)) : R;
        voffA[i] = (unsigned)(R * K + C) * 2u; voffB[i] = (unsigned)(Rb * K + C) * 2u; }
    const size_t kstep = (size_t)(BK * 2);
    const size_t hstep = (size_t)HALF * K * 2;
    const size_t tstep = 2 * hstep;
    const unsigned ldsw = (unsigned)wid * 1024u;
    const int aoff = lds_byte(wr * 64 + fr, fq * 8), boff = lds_byte(wc * 32 + fr, fq * 8);
#define PG8_SA(b, h) (((b) * 2 + (h)) * HTB)
#define PG8_SB(b, h) ((4 + (b) * 2 + (h)) * HTB)
#define PG8_STAGE(bufoff, gbase, voff) do { _Pragma("unroll") for (int _i = 0; _i < 2; ++_i) \
        __builtin_amdgcn_global_load_lds((const unsigned*)((const char*)(gbase) + (voff)[_i]), (PG8_LAS unsigned*)(lds + (bufoff) + ldsw + _i * 8192), 16, 0, 0); } while (0)
#define PG8_LDA(dst, b, h) do { _Pragma("unroll") for (int m = 0; m < 4; ++m) _Pragma("unroll") for (int k = 0; k < 2; ++k) dst[m][k] = *(const PG8_LAS bf16x8*)(lds + PG8_SA(b, h) + aoff + m * 2048 + k * 1024); } while (0)
#define PG8_LDB(dst, b, h) do { _Pragma("unroll") for (int n = 0; n < 2; ++n) _Pragma("unroll") for (int k = 0; k < 2; ++k) dst[n][k] = *(const PG8_LAS bf16x8*)(lds + PG8_SB(b, h) + boff + n * 2048 + k * 1024); } while (0)
#define PG8_MMA(ai, bj, At, Bt) do { __builtin_amdgcn_s_setprio(1); _Pragma("unroll") for (int m = 0; m < 4; ++m) _Pragma("unroll") for (int n = 0; n < 2; ++n) _Pragma("unroll") for (int k = 0; k < 2; ++k) \
        acc[ai][bj][m][n] = __builtin_amdgcn_mfma_f32_16x16x32_bf16(Bt[n][k], At[m][k], acc[ai][bj][m][n], 0, 0, 0); __builtin_amdgcn_s_setprio(0); } while (0)
#define PG8_WAIT_V(n) asm volatile("s_waitcnt vmcnt(" #n ")" ::: "memory")
#define PG8_WAIT_L(n) asm volatile("s_waitcnt lgkmcnt(" #n ")" ::: "memory")
#define PG8_BAR __builtin_amdgcn_s_barrier()
#define PG8_SCHED __builtin_amdgcn_sched_barrier(0)
    Unit cur, nxt; int ui = 0;
    if (!S.next(0, cur)) return;
    f32x4 acc[2][2][4][2];
#pragma unroll
    for (int a = 0; a < 2; ++a)
#pragma unroll
        for (int b = 0; b < 2; ++b)
#pragma unroll
            for (int m = 0; m < 4; ++m)
#pragma unroll
                for (int n = 0; n < 2; ++n) acc[a][b][m][n] = (f32x4){0.f, 0.f, 0.f, 0.f};
    bf16x8 At[4][2], B0[2][2], B1[2][2];
    const char* cA = (const char*)g.A + (size_t)cur.pm * tstep; const char* cB = (const char*)g.Bt + (size_t)cur.pn * tstep;
    S.a_ready(cur);
    if constexpr (SP2) {
        PG8_STAGE(PG8_SB(0, 0), cB, voffB); PG8_STAGE(PG8_SB(0, 1), cB + hstep, voffB); PG8_STAGE(PG8_SA(0, 0), cA, voffA); PG8_STAGE(PG8_SA(0, 1), cA + hstep, voffA);
        if (wr == 1) PG8_BAR;
        PG8_WAIT_V(2); PG8_BAR;
        PG8_STAGE(PG8_SB(1, 0), cB + kstep, voffB); PG8_STAGE(PG8_SA(1, 0), cA + kstep, voffA); PG8_STAGE(PG8_SB(1, 1), cB + hstep + kstep, voffB);
        PG8_WAIT_V(6); PG8_BAR;
    } else {
        PG8_STAGE(PG8_SB(0, 0), cB, voffB); PG8_STAGE(PG8_SA(0, 0), cA, voffA); PG8_STAGE(PG8_SB(0, 1), cB + hstep, voffB); PG8_STAGE(PG8_SA(0, 1), cA + hstep, voffA);
        if (wr == 1) PG8_BAR;
        PG8_WAIT_V(4); PG8_BAR;
        PG8_STAGE(PG8_SB(1, 0), cB + kstep, voffB); PG8_STAGE(PG8_SA(1, 0), cA + kstep, voffA); PG8_STAGE(PG8_SB(1, 1), cB + hstep + kstep, voffB);
        PG8_WAIT_V(6); PG8_BAR;
    }
    for (;;) {
        const bool has_next = S.next(ui + 1, nxt);
        const char* nA = has_next ? (const char*)g.A + (size_t)nxt.pm * tstep : cA; const char* nB = has_next ? (const char*)g.Bt + (size_t)nxt.pn * tstep : cB;
        for (int t = 0; t < nt; t += 2) {
            const bool last = (t == nt - 2);
            const char* a1 = cA + (size_t)(t + 1) * kstep;
            const char* a2 = last ? nA : cA + (size_t)(t + 2) * kstep; const char* b2 = last ? nB : cB + (size_t)(t + 2) * kstep;
            const char* a3 = a2 + kstep; const char* b3 = b2 + kstep;
            if (last && has_next) S.a_ready(nxt);
            if constexpr (SP2) {
            PG8_LDB(B0, 0, 0); PG8_LDB(B1, 0, 1); PG8_SCHED; PG8_LDA(At, 0, 0); PG8_STAGE(PG8_SA(1, 1), a1 + hstep, voffA);
            PG8_WAIT_V(8); PG8_WAIT_L(0); PG8_BAR; PG8_MMA(0, 0, At, B0); PG8_MMA(0, 1, At, B1); PG8_BAR; PG8_SCHED;
            PG8_LDA(At, 0, 1); PG8_STAGE(PG8_SB(0, 0), b2, voffB); PG8_STAGE(PG8_SB(0, 1), b2 + hstep, voffB); PG8_STAGE(PG8_SA(0, 0), a2, voffA);
            PG8_WAIT_V(8); PG8_WAIT_L(0); PG8_BAR; PG8_MMA(1, 0, At, B0); PG8_MMA(1, 1, At, B1); PG8_BAR; PG8_SCHED;
            PG8_LDB(B0, 1, 0); PG8_LDB(B1, 1, 1); PG8_SCHED; PG8_LDA(At, 1, 0); PG8_STAGE(PG8_SA(0, 1), a2 + hstep, voffA);
            PG8_WAIT_V(8); PG8_WAIT_L(0); PG8_BAR; PG8_MMA(0, 0, At, B0); PG8_MMA(0, 1, At, B1); PG8_BAR; PG8_SCHED;
            PG8_LDA(At, 1, 1); PG8_STAGE(PG8_SB(1, 0), b3, voffB); PG8_STAGE(PG8_SB(1, 1), b3 + hstep, voffB); PG8_STAGE(PG8_SA(1, 0), a3, voffA);
            PG8_WAIT_V(8); PG8_WAIT_L(0); PG8_BAR; PG8_MMA(1, 0, At, B0); PG8_MMA(1, 1, At, B1); PG8_BAR; PG8_SCHED;
            } else {
            PG8_LDB(B0, 0, 0); PG8_SCHED; PG8_LDA(At, 0, 0); PG8_STAGE(PG8_SA(1, 1), a1 + hstep, voffA);
            PG8_WAIT_L(8); PG8_BAR; PG8_WAIT_L(0); PG8_MMA(0, 0, At, B0); PG8_BAR; PG8_SCHED;
            PG8_LDB(B1, 0, 1); PG8_STAGE(PG8_SB(0, 0), b2, voffB);
            PG8_BAR; PG8_WAIT_L(0); PG8_MMA(0, 1, At, B1); PG8_BAR;
            PG8_LDA(At, 0, 1); PG8_STAGE(PG8_SA(0, 0), a2, voffA);
            PG8_BAR; PG8_WAIT_L(0); PG8_MMA(1, 0, At, B0); PG8_BAR; PG8_SCHED;
            PG8_STAGE(PG8_SB(0, 1), b2 + hstep, voffB);
            PG8_WAIT_V(6); PG8_BAR; PG8_MMA(1, 1, At, B1); PG8_BAR;
            PG8_LDB(B0, 1, 0); PG8_SCHED; PG8_LDA(At, 1, 0); PG8_STAGE(PG8_SA(0, 1), a2 + hstep, voffA);
            PG8_WAIT_L(8); PG8_BAR; PG8_WAIT_L(0); PG8_MMA(0, 0, At, B0); PG8_BAR; PG8_SCHED;
            PG8_LDB(B1, 1, 1); PG8_STAGE(PG8_SB(1, 0), b3, voffB);
            PG8_BAR; PG8_WAIT_L(0); PG8_MMA(0, 1, At, B1); PG8_BAR;
            PG8_LDA(At, 1, 1); PG8_STAGE(PG8_SA(1, 0), a3, voffA);
            PG8_BAR; PG8_WAIT_L(0); PG8_MMA(1, 0, At, B0); PG8_BAR; PG8_SCHED;
            PG8_STAGE(PG8_SB(1, 1), b3 + hstep, voffB);
            PG8_WAIT_V(6); PG8_BAR; PG8_MMA(1, 1, At, B1); PG8_BAR;
            }
        }
        if constexpr (ALIGN_EPI) { if (wr == 0) PG8_BAR; }
        if constexpr (!Epi::AFTER_DRAIN) { E(acc, cur, wr, wc, fr, fq); S.done(cur); }
        if (!has_next) break;
#pragma unroll
        for (int a = 0; a < 2; ++a)
#pragma unroll
            for (int b = 0; b < 2; ++b)
#pragma unroll
                for (int m = 0; m < 4; ++m)
#pragma unroll
                    for (int n = 0; n < 2; ++n) acc[a][b][m][n] = (f32x4){0.f, 0.f, 0.f, 0.f};
        cur = nxt; cA = nA; cB = nB; ++ui;
        if constexpr (ALIGN_EPI) { if (wr == 1) PG8_BAR; }
    }
    PG8_WAIT_V(0);
    if constexpr (!ALIGN_EPI) { if (wr == 0) PG8_BAR; }
    PG8_BAR;
    if constexpr (Epi::AFTER_DRAIN) { E.fused(acc, cur, wr, wc, fr, fq, lds, wid, lane); S.done(cur); }
#undef PG8_SA
#undef PG8_SB
#undef PG8_STAGE
#undef PG8_LDA
#undef PG8_LDB
#undef PG8_MMA
#undef PG8_WAIT_V
#undef PG8_WAIT_L
#undef PG8_BAR
#undef PG8_SCHED
}
}

#define LAS __attribute__((address_space(3)))
typedef unsigned short bf16_t;
typedef short bf16x8 __attribute__((ext_vector_type(8)));
typedef short s16x4 __attribute__((ext_vector_type(4)));
typedef float f32x4 __attribute__((ext_vector_type(4)));
typedef float f32x16 __attribute__((ext_vector_type(16)));
typedef unsigned u32x4 __attribute__((ext_vector_type(4)));
typedef unsigned u32x2 __attribute__((ext_vector_type(2)));

constexpr int DM = 1024, NB = 32, SEQ = 2048, MP = NB * SEQ, NSB = 8, NST = 32, MS = NSB * NST, MT = MP + MS;
constexpr int PAST = 2048, LAC = 512, DIN = 4104, NREL = 257;
constexpr int LAS_LEN = LAC + NST  , LBS_LEN = PAST + NST  ;
constexpr float LOG2E = 1.4426950408889634f, QSCALE = 0.125f * LOG2E, RMS_EPS = 1e-6f;

constexpr size_t O_Y = 0;
constexpr size_t O_AKP = (size_t)MT * 1024;
constexpr size_t O_AVP = O_AKP + (size_t)NB * 512 * 512;
constexpr size_t O_BKP = O_AVP + (size_t)NB * 512 * 512;
constexpr size_t O_BVP = O_BKP + (size_t)MP * 512;
constexpr size_t O_LFP = O_BVP + (size_t)MP * 512;
constexpr size_t O_AKS = O_LFP + (size_t)MP * 8;
constexpr size_t O_AVS = O_AKS + (size_t)MS * 512;
constexpr size_t O_BKS = O_AVS + (size_t)MS * 512;
constexpr size_t O_BVS = O_BKS + (size_t)MS * 512;
constexpr size_t O_LFS = O_BVS + (size_t)MS * 512;
constexpr size_t O_END = O_LFS + (size_t)MS * 8;

constexpr size_t MiB = 1u << 20;
constexpr size_t WS_WIN = 0, WS_WOUT = 8 * MiB, WS_C2P = 10 * MiB, WS_C2S = 12 * MiB, WS_PS = 13 * MiB;
constexpr size_t WS_KAS = 18 * MiB, WS_VAS = 23 * MiB, WS_KBS = 28 * MiB, WS_VBS = 45 * MiB;
constexpr size_t WS_H = 64 * MiB;
constexpr size_t WS_SEG = 200 * MiB, SEG_STRIDE = 66 * MiB;
constexpr size_t WS_END = WS_SEG + 8 * SEG_STRIDE;
static_assert((size_t)33 * 8 * 2048 * 64 * 2 <= SEG_STRIDE && (size_t)MT * 1024 * 2 <= WS_SEG - WS_H && (size_t)MT * 64 <= WS_KAS - WS_PS, "ws map");
static_assert((size_t)NSB * LAS_LEN * 512 * 2 <= 5 * MiB && (size_t)NSB * LBS_LEN * 512 * 2 <= 17 * MiB, "ws map");

constexpr int LDS_BYTES = 147456;

struct Params {
    const float* xp; const float* xs; const float* cak; const float* cav; const float* cbk; const float* cbv; const float* cblf;
    const float* gain; const float* win; const float* bfg; const float* relb; const float* wout; const float* fgain;
    float* out; unsigned char* ws;
};

__device__ __forceinline__ float wave_sum(float v) {
#pragma unroll
    for (int o = 1; o < 64; o <<= 1) v += __shfl_xor(v, o);
    return v;
}
typedef float f32x2_t __attribute__((ext_vector_type(2))); typedef __bf16 bf16x2_t __attribute__((ext_vector_type(2)));
__device__ __forceinline__ unsigned pk2(float lo, float hi) { f32x2_t v = {lo, hi}; bf16x2_t b = __builtin_convertvector(v, bf16x2_t); return __builtin_bit_cast(unsigned, b); }
__device__ __forceinline__ float bf_lo(unsigned w) { return __uint_as_float(w << 16); }
__device__ __forceinline__ float bf_hi(unsigned w) { return __uint_as_float(w & 0xffff0000u); }

struct EpiProj {
    static constexpr bool PERM = true, AFTER_DRAIN = false;
    unsigned char* ws; float* out;
    __device__ __forceinline__ void operator()(const pg8::f32x4 (&acc)[2][2][4][2], const pg8::Unit& u, int wr, int wc, int fr, int fq) const {
        const int seg = u.pn >> 1, kind = seg & 3, grp = seg >> 2;
        const bool smp = (u.pm == MP / 256);
        const bool kv = (kind == 1 || kind == 2);
        const int colw = (u.pn & 1) * 256 + wc * 32 + 8 * fq;
        bf16_t* bbase = (bf16_t*)(ws + WS_SEG + (size_t)seg * SEG_STRIDE);
        int sL = 0, sP = 0;
        if (smp && kv) {
            if (grp == 0) { bbase = (bf16_t*)(ws + (kind == 1 ? WS_KAS : WS_VAS)); sL = LAS_LEN; sP = LAC; }
            else          { bbase = (bf16_t*)(ws + (kind == 1 ? WS_KBS : WS_VBS)); sL = LBS_LEN; sP = PAST; }
        }
        float* fdst = nullptr; unsigned frow0 = 0;
        if (kv) {
            if (smp) { fdst = out + (grp == 0 ? (kind == 1 ? O_AKS : O_AVS) : (kind == 1 ? O_BKS : O_BVS)); }
            else if (grp == 1) { fdst = out + (kind == 1 ? O_BKP : O_BVP); frow0 = (unsigned)u.pm * 256u; }
            else if ((u.pm & 7) >= 6) { fdst = out + (kind == 1 ? O_AKP : O_AVP); frow0 = (unsigned)(u.pm >> 3) * 512u + (unsigned)((u.pm & 7) - 6) * 256u; }
        }
        const int hd0 = (u.pn & 1) * 4 + (wc >> 1), dcol = (wc & 1) * 32 + 8 * fq;
        const unsigned bat = (unsigned)(u.pm >> 3), t0 = (unsigned)(u.pm & 7) * 256u;
#pragma unroll
        for (int ai = 0; ai < 2; ++ai)
#pragma unroll
            for (int m = 0; m < 4; ++m) {
                const int rt = ai * 128 + wr * 64 + m * 16 + fr;
#pragma unroll
                for (int bj = 0; bj < 2; ++bj) {
                    const unsigned head = (unsigned)(hd0 + 2 * bj);
                    const unsigned bidx = sL ? ((((unsigned)(rt >> 5) * 8u + head) * (unsigned)sL + (unsigned)(sP + (rt & 31))) * 64u + (unsigned)dcol)
                                             : (((bat * 8u + head) * 2048u + t0 + (unsigned)rt) * 64u + (unsigned)dcol);
                    pg8::f32x4 v0 = acc[ai][bj][m][0], v1 = acc[ai][bj][m][1];
                    if (fdst) { float* fp = fdst + ((frow0 + (unsigned)rt) * 512u + (unsigned)(colw + bj * 128)); *(pg8::f32x4*)fp = v0; *(pg8::f32x4*)(fp + 4) = v1; }
                    if (kind == 0) { v0 = v0 * QSCALE; v1 = v1 * QSCALE; }
                    else if (kind == 3) {
#pragma unroll
                        for (int e = 0; e < 4; ++e) {
                            v0[e] = v0[e] * __builtin_amdgcn_rcpf(1.0f + __builtin_amdgcn_exp2f(-LOG2E * v0[e]));
                            v1[e] = v1[e] * __builtin_amdgcn_rcpf(1.0f + __builtin_amdgcn_exp2f(-LOG2E * v1[e]));
                        }
                    }
                    pg8::u32x4 w; w.x = pk2(v0[0], v0[1]); w.y = pk2(v0[2], v0[3]); w.z = pk2(v1[0], v1[1]); w.w = pk2(v1[2], v1[3]);
                    *(pg8::u32x4*)(bbase + bidx) = w;
                }
            }
    }
};

struct EpiOut {
    static constexpr bool PERM = true, AFTER_DRAIN = false;
    bf16_t* mo;
    __device__ __forceinline__ void operator()(const pg8::f32x4 (&acc)[2][2][4][2], const pg8::Unit& u, int wr, int wc, int fr, int fq) const {
        const unsigned c0 = (unsigned)(u.pn * 256 + wc * 32 + 8 * fq);
#pragma unroll
        for (int ai = 0; ai < 2; ++ai)
#pragma unroll
            for (int m = 0; m < 4; ++m) {
                const unsigned grow = (unsigned)u.pm * 256u + (unsigned)(ai * 128 + wr * 64 + m * 16 + fr);
#pragma unroll
                for (int bj = 0; bj < 2; ++bj) {
                    const pg8::f32x4 v0 = acc[ai][bj][m][0], v1 = acc[ai][bj][m][1];
                    pg8::u32x4 w; w.x = pk2(v0[0], v0[1]); w.y = pk2(v0[2], v0[3]); w.z = pk2(v1[0], v1[1]); w.w = pk2(v1[2], v1[3]);
                    *(pg8::u32x4*)(mo + (grow * 1024u + c0 + (unsigned)(bj * 128))) = w;
                }
            }
    }
};

template <class F>
__device__ __forceinline__ void mini_gemm64(const bf16_t* __restrict__ A, const bf16_t* __restrict__ Bt, int wave, int lane, F&& epi) {
    const int fr = lane & 15, fq = lane >> 4;
    const bf16_t* ap = A + (size_t)(16 * (wave >> 1) + fr) * 1024 + 8 * fq;
    const bf16_t* b0 = Bt + (size_t)(32 * (wave & 1) + fr) * 1024 + 8 * fq;
    const bf16_t* b1 = b0 + 16 * 1024;
    f32x4 acc0 = {0.f, 0.f, 0.f, 0.f}, acc1 = {0.f, 0.f, 0.f, 0.f};
#pragma unroll 8
    for (int ks = 0; ks < 32; ++ks) {
        const bf16x8 a = *(const bf16x8*)(ap + ks * 32), x0 = *(const bf16x8*)(b0 + ks * 32), x1 = *(const bf16x8*)(b1 + ks * 32);
        acc0 = __builtin_amdgcn_mfma_f32_16x16x32_bf16(x0, a, acc0, 0, 0, 0);
        acc1 = __builtin_amdgcn_mfma_f32_16x16x32_bf16(x1, a, acc1, 0, 0, 0);
    }
    const int row = 16 * (wave >> 1) + fr, col = 32 * (wave & 1) + 4 * fq;
    epi(row, col, acc0); epi(row, col + 16, acc1);
}

__device__ __forceinline__ void p0_transpose_item(const float* W, int ldw, int ncols, int K, bf16_t* WT, LAS float* scr, int item, int lane) {
    const int nblk = ncols / 32, kb = item / nblk, nb = item % nblk, k0 = 64 * kb, n0 = 32 * nb;
#pragma unroll 8
    for (int i = 0; i < 32; ++i) { const int kk = 2 * i + (lane >> 5); scr[kk * 33 + (lane & 31)] = W[(size_t)(k0 + kk) * ldw + n0 + (lane & 31)]; }
    asm volatile("s_waitcnt lgkmcnt(0)" ::: "memory");
    const int c = lane & 7;
#pragma unroll
    for (int j = 0; j < 4; ++j) { const int n = (lane >> 3) + 8 * j; const LAS float* s = scr + (8 * c) * 33 + n;
        u32x4 o; o.x = pk2(s[0 * 33], s[1 * 33]); o.y = pk2(s[2 * 33], s[3 * 33]); o.z = pk2(s[4 * 33], s[5 * 33]); o.w = pk2(s[6 * 33], s[7 * 33]);
        *(u32x4*)(WT + (size_t)(n0 + n) * K + k0 + 8 * c) = o; }
    asm volatile("s_waitcnt lgkmcnt(0)" ::: "memory");
}

__device__ __forceinline__ void conv_chunk(const float* src, bf16_t* dst, int c, int pshift, int L) {
    const int row = c >> 6, col8 = c & 63, b = row >> pshift, pos = row & ((1 << pshift) - 1);
    const f32x4 a = *(const f32x4*)(src + (size_t)c * 8), d = *(const f32x4*)(src + (size_t)c * 8 + 4);
    u32x4 o; o.x = pk2(a[0], a[1]); o.y = pk2(a[2], a[3]); o.z = pk2(d[0], d[1]); o.w = pk2(d[2], d[3]);
    *(u32x4*)(dst + (((size_t)(b * 8 + (col8 >> 3)) * L + pos) * 64 + (col8 & 7) * 8)) = o;
}

__device__ __forceinline__ void phase0(const Params& P, LAS unsigned char* lds, int tid, int lane, int wave) {
    const int G = gridDim.x, gw = blockIdx.x * 8 + wave, NGW = G * 8;
    bf16_t* Win_t = (bf16_t*)(P.ws + WS_WIN); bf16_t* Wout_t = (bf16_t*)(P.ws + WS_WOUT); bf16_t* H = (bf16_t*)(P.ws + WS_H);
    LAS float* wfL = (LAS float*)(lds + 69632);
    for (int i = tid; i < 1024 * 8; i += 512) wfL[i] = P.win[(size_t)(i >> 3) * DIN + 4096 + (i & 7)];
    LAS float* scr = (LAS float*)(lds + wave * 8704);
    for (int it = gw; it < 2048 + 512; it += NGW) {
        if (it < 2048) p0_transpose_item(P.win, DIN, 4096, 1024, Win_t, scr, it, lane);
        else p0_transpose_item(P.wout, 1024, 1024, 1024, Wout_t, scr, it - 2048, lane);
    }
    __syncthreads();
    f32x4 g4[4];
#pragma unroll
    for (int j = 0; j < 4; ++j) g4[j] = *(const f32x4*)(P.gain + 4 * lane + 256 * j);
    const float bfv = P.bfg[lane & 7];
    for (int m = gw; m < MT; m += NGW) {
        const float* xrow = (m < MP) ? P.xp + (size_t)m * 1024 : P.xs + (size_t)(m - MP) * 1024;
        f32x4 v[4]; float ss = 0.f;
#pragma unroll
        for (int j = 0; j < 4; ++j) { v[j] = *(const f32x4*)(xrow + 4 * lane + 256 * j); ss += (v[j][0] * v[j][0] + v[j][1] * v[j][1]) + (v[j][2] * v[j][2] + v[j][3] * v[j][3]); }
        ss = wave_sum(ss);
        const float rstd = 1.0f / sqrtf(ss * (1.0f / 1024.0f) + RMS_EPS);
        float z0 = 0.f, z1 = 0.f, z2 = 0.f, z3 = 0.f, z4 = 0.f, z5 = 0.f, z6 = 0.f, z7 = 0.f;
#pragma unroll
        for (int j = 0; j < 4; ++j) {
            const f32x4 hv = v[j] * rstd * g4[j];
            u32x2 w; w.x = pk2(hv[0], hv[1]); w.y = pk2(hv[2], hv[3]);
            *(u32x2*)(H + (size_t)m * 1024 + 4 * lane + 256 * j) = w;
#pragma unroll
            for (int e = 0; e < 4; ++e) {
                const int k = 4 * lane + 256 * j + e;
                const f32x4 w0 = *(const LAS f32x4*)(wfL + k * 8), w1 = *(const LAS f32x4*)(wfL + k * 8 + 4);
                z0 += hv[e] * w0[0]; z1 += hv[e] * w0[1]; z2 += hv[e] * w0[2]; z3 += hv[e] * w0[3];
                z4 += hv[e] * w1[0]; z5 += hv[e] * w1[1]; z6 += hv[e] * w1[2]; z7 += hv[e] * w1[3];
            }
        }
        z0 = wave_sum(z0); z1 = wave_sum(z1); z2 = wave_sum(z2); z3 = wave_sum(z3); z4 = wave_sum(z4); z5 = wave_sum(z5); z6 = wave_sum(z6); z7 = wave_sum(z7);
        float zs = z0; zs = (lane == 1) ? z1 : zs; zs = (lane == 2) ? z2 : zs; zs = (lane == 3) ? z3 : zs; zs = (lane == 4) ? z4 : zs; zs = (lane == 5) ? z5 : zs; zs = (lane == 6) ? z6 : zs; zs = (lane == 7) ? z7 : zs;
        if (lane < 8) {
            const float t = zs + bfv;
            const float lf = fminf(t, 0.f) - log1pf(expf(-fabsf(t)));
            if (m < MP) P.out[O_LFP + (size_t)m * 8 + lane] = lf; else P.out[O_LFS + (size_t)(m - MP) * 8 + lane] = lf;
        }
    }
    const int gt = blockIdx.x * 512 + tid, NT = G * 512;
    for (int c = gt; c < NSB * LAC * 64; c += NT) { conv_chunk(P.cak, (bf16_t*)(P.ws + WS_KAS), c, 9, LAS_LEN); conv_chunk(P.cav, (bf16_t*)(P.ws + WS_VAS), c, 9, LAS_LEN); }
    for (int c = gt; c < NSB * PAST * 64; c += NT) { conv_chunk(P.cbk, (bf16_t*)(P.ws + WS_KBS), c, 11, LBS_LEN); conv_chunk(P.cbv, (bf16_t*)(P.ws + WS_VBS), c, 11, LBS_LEN); }
}

template <int PER, class LD>
__device__ __forceinline__ void block_cumsum(int n, LD load, float* dst, LAS float* red, int tid) {
    const int lane = tid & 63, w = tid >> 6;
    float v[PER]; float run = 0.f;
#pragma unroll
    for (int e = 0; e < PER; ++e) { const int t = tid * PER + e; const float x = (t < n) ? load(t) : 0.f; run += x; v[e] = run; }
    float inc = run;
#pragma unroll
    for (int o = 1; o < 64; o <<= 1) { const float y = __shfl_up(inc, o); if (lane >= o) inc += y; }
    if (lane == 63) red[w] = inc;
    __syncthreads();
    float off = inc - run;
#pragma unroll
    for (int i = 0; i < 8; ++i) off += (i < w) ? red[i] : 0.f;
#pragma unroll
    for (int e = 0; e < PER; ++e) { const int t = tid * PER + e; if (t < n) dst[t] = (v[e] + off) * LOG2E; }
    __syncthreads();
}

namespace att {
constexpr float THR = 8.0f;
__device__ __forceinline__ int crow(int r, int hi) { return (r & 3) + 8 * (r >> 2) + 4 * hi; }
__device__ __forceinline__ float xhalf_max(float m) {
    auto rr = __builtin_amdgcn_permlane32_swap(__float_as_uint(m), __float_as_uint(m), false, false);
    return fmaxf(__uint_as_float(rr[0]), __uint_as_float(rr[1]));
}
__device__ __forceinline__ float xhalf_sum(float m) {
    auto rr = __builtin_amdgcn_permlane32_swap(__float_as_uint(m), __float_as_uint(m), false, false);
    return __uint_as_float(rr[0]) + __uint_as_float(rr[1]);
}
struct St { float m, l; f32x16 o0, o1; };
__device__ __forceinline__ void st_init(St& S) {
    S.m = 0.f; S.l = 0.f;
#pragma unroll
    for (int r = 0; r < 16; ++r) { S.o0[r] = 0.f; S.o1[r] = 0.f; }
}

template <int MODE>
__device__ __forceinline__ void step(St& S, const bf16x8 (&qf)[4], int kb, int qpos0, bool diag, bool first, float cq, float cfar, const LAS float* tab,
                                     const LAS unsigned char* kimg, unsigned vaddr, int r32, int hi) {
    bf16x8 kf[4];
#pragma unroll
    for (int d0 = 0; d0 < 4; ++d0) kf[d0] = *(const LAS bf16x8*)(kimg + r32 * 128 + (((d0 * 2 + hi) ^ ((r32 >> 1) & 7)) << 4));
    f32x16 s;
    if (MODE == 1) {
        const float nm = cq - S.m;
#pragma unroll
        for (int g = 0; g < 4; ++g) { const f32x4 ck = *(const LAS f32x4*)(tab + kb * 32 + 8 * g + 4 * hi);
#pragma unroll
            for (int e = 0; e < 4; ++e) s[4 * g + e] = nm - ck[e]; }
    } else {
        if (qpos0 - (kb * 32 + 31) >= 128) {
            const float c = cfar - S.m;
#pragma unroll
            for (int r = 0; r < 16; ++r) s[r] = c;
        } else {
            const int dd = qpos0 + r32 - kb * 32 + 128;
#pragma unroll
            for (int r = 0; r < 16; ++r) { int idx = dd - crow(r, hi); idx = idx < 0 ? 0 : (idx > 256 ? 256 : idx); s[r] = tab[idx] - S.m; }
        }
    }
#pragma unroll
    for (int d0 = 0; d0 < 4; ++d0) s = __builtin_amdgcn_mfma_f32_32x32x16_bf16(kf[d0], qf[d0], s, 0, 0, 0);
    if (MODE == 1 && diag) {
#pragma unroll
        for (int r = 0; r < 16; ++r) if (crow(r, hi) > r32) s[r] = -1e30f;
    }
    float rm = fmaxf(fmaxf(s[0], s[1]), fmaxf(s[2], s[3]));
#pragma unroll
    for (int r = 4; r < 16; r += 4) rm = fmaxf(rm, fmaxf(fmaxf(s[r], s[r + 1]), fmaxf(s[r + 2], s[r + 3])));
    rm = xhalf_max(rm);
    if (first || __any(rm > THR)) {
        const float dl = first ? rm : fmaxf(rm, 0.f); S.m += dl;
        const float f = first ? 1.0f : __builtin_amdgcn_exp2f(-dl); S.l *= f;
#pragma unroll
        for (int r = 0; r < 16; ++r) { s[r] -= dl; S.o0[r] *= f; S.o1[r] *= f; }
    }
    float ls = 0.f;
#pragma unroll
    for (int r = 0; r < 16; ++r) { s[r] = __builtin_amdgcn_exp2f(s[r]); ls += s[r]; }
    S.l += ls;
    u32x4 pw0, pw1;
    pw0.x = pk2(s[0], s[1]); pw0.y = pk2(s[2], s[3]); pw0.z = pk2(s[4], s[5]); pw0.w = pk2(s[6], s[7]);
    pw1.x = pk2(s[8], s[9]); pw1.y = pk2(s[10], s[11]); pw1.z = pk2(s[12], s[13]); pw1.w = pk2(s[14], s[15]);
    const bf16x8 pf0 = __builtin_bit_cast(bf16x8, pw0), pf1 = __builtin_bit_cast(bf16x8, pw1);
    s16x4 vlo[4], vhi[4];
#define ATT_TR(dst, off) asm volatile("ds_read_b64_tr_b16 %0, %1 offset:%c2" : "=&v"(dst) : "v"(vaddr), "i"(off) : "memory")
    ATT_TR(vlo[0], 0);    ATT_TR(vhi[0], 1024);
    ATT_TR(vlo[1], 2048); ATT_TR(vhi[1], 3072);
    ATT_TR(vlo[2], 512);  ATT_TR(vhi[2], 1536);
    ATT_TR(vlo[3], 2560); ATT_TR(vhi[3], 3584);
#undef ATT_TR
    asm volatile("s_waitcnt lgkmcnt(0)" ::: "memory");
    __builtin_amdgcn_sched_barrier(0);
#define ATT_VF(i) (bf16x8){vlo[i][0], vlo[i][1], vlo[i][2], vlo[i][3], vhi[i][0], vhi[i][1], vhi[i][2], vhi[i][3]}
    S.o0 = __builtin_amdgcn_mfma_f32_32x32x16_bf16(ATT_VF(0), pf0, S.o0, 0, 0, 0);
    S.o0 = __builtin_amdgcn_mfma_f32_32x32x16_bf16(ATT_VF(1), pf1, S.o0, 0, 0, 0);
    S.o1 = __builtin_amdgcn_mfma_f32_32x32x16_bf16(ATT_VF(2), pf0, S.o1, 0, 0, 0);
    S.o1 = __builtin_amdgcn_mfma_f32_32x32x16_bf16(ATT_VF(3), pf1, S.o1, 0, 0, 0);
#undef ATT_VF
}
__device__ __forceinline__ float max3f(float a, float b, float c) { float r; asm("v_max3_f32 %0, %1, %2, %3" : "=v"(r) : "v"(a), "v"(b), "v"(c)); return r; }
template <int MODE>
__device__ __forceinline__ void step64(St& S, const bf16x8 (&qf)[4], int t, int qpos0, bool diag, bool first, float cq, float cfar, const LAS float* tab,
                                       const LAS unsigned char* buf, unsigned vaddr, int r32, int hi) {
    bf16x8 ka[4], kc[4];
#pragma unroll
    for (int d0 = 0; d0 < 4; ++d0) { const int o = r32 * 128 + (((d0 * 2 + hi) ^ ((r32 >> 1) & 7)) << 4); ka[d0] = *(const LAS bf16x8*)(buf + o); kc[d0] = *(const LAS bf16x8*)(buf + 4096 + o); }
    f32x16 sa, sb;
    if (MODE == 1) {
        const float nm = cq - S.m;
#pragma unroll
        for (int g = 0; g < 4; ++g) { const f32x4 c0 = *(const LAS f32x4*)(tab + t * 64 + 8 * g + 4 * hi), c1 = *(const LAS f32x4*)(tab + t * 64 + 32 + 8 * g + 4 * hi);
#pragma unroll
            for (int e = 0; e < 4; ++e) { sa[4 * g + e] = nm - c0[e]; sb[4 * g + e] = nm - c1[e]; } }
    } else {
        if (qpos0 - (t * 64 + 31) >= 128) {
            const float c = cfar - S.m;
#pragma unroll
            for (int r = 0; r < 16; ++r) sa[r] = c;
        } else {
            const int dd = qpos0 + r32 - t * 64 + 128;
#pragma unroll
            for (int r = 0; r < 16; ++r) { int idx = dd - crow(r, hi); idx = idx < 0 ? 0 : (idx > 256 ? 256 : idx); sa[r] = tab[idx] - S.m; }
        }
        if (qpos0 - (t * 64 + 63) >= 128) {
            const float c = cfar - S.m;
#pragma unroll
            for (int r = 0; r < 16; ++r) sb[r] = c;
        } else {
            const int dd = qpos0 + r32 - t * 64 - 32 + 128;
#pragma unroll
            for (int r = 0; r < 16; ++r) { int idx = dd - crow(r, hi); idx = idx < 0 ? 0 : (idx > 256 ? 256 : idx); sb[r] = tab[idx] - S.m; }
        }
    }
#pragma unroll
    for (int d0 = 0; d0 < 4; ++d0) { sa = __builtin_amdgcn_mfma_f32_32x32x16_bf16(ka[d0], qf[d0], sa, 0, 0, 0); sb = __builtin_amdgcn_mfma_f32_32x32x16_bf16(kc[d0], qf[d0], sb, 0, 0, 0); }
    s16x4 vlo[8], vhi[8];
#define ATT_TR(dst, off) asm volatile("ds_read_b64_tr_b16 %0, %1 offset:%c2" : "=&v"(dst) : "v"(vaddr), "i"(off) : "memory")
    ATT_TR(vlo[0], 0);           ATT_TR(vhi[0], 1024);          ATT_TR(vlo[1], 2048);        ATT_TR(vhi[1], 3072);
    ATT_TR(vlo[2], 512);         ATT_TR(vhi[2], 1536);          ATT_TR(vlo[3], 2560);        ATT_TR(vhi[3], 3584);
    ATT_TR(vlo[4], 4096 + 0);    ATT_TR(vhi[4], 4096 + 1024);   ATT_TR(vlo[5], 4096 + 2048); ATT_TR(vhi[5], 4096 + 3072);
    ATT_TR(vlo[6], 4096 + 512);  ATT_TR(vhi[6], 4096 + 1536);   ATT_TR(vlo[7], 4096 + 2560); ATT_TR(vhi[7], 4096 + 3584);
#undef ATT_TR
    if (MODE == 1 && diag) {
        const int qrel = qpos0 - t * 64 + r32;
#pragma unroll
        for (int r = 0; r < 16; ++r) { if (crow(r, hi) > qrel) sa[r] = -1e30f; if (crow(r, hi) + 32 > qrel) sb[r] = -1e30f; }
    }
    float r0 = max3f(sa[0], sa[1], sa[2]), r1 = max3f(sb[0], sb[1], sb[2]);
#pragma unroll
    for (int r = 3; r < 15; r += 2) { r0 = max3f(r0, sa[r], sa[r + 1]); r1 = max3f(r1, sb[r], sb[r + 1]); }
    float rm = max3f(r0, r1, fmaxf(sa[15], sb[15]));
    rm = xhalf_max(rm);
    if (first || __any(rm > THR)) {
        const float dl = first ? rm : fmaxf(rm, 0.f); S.m += dl;
        const float f = first ? 1.0f : __builtin_amdgcn_exp2f(-dl); S.l *= f;
#pragma unroll
        for (int r = 0; r < 16; ++r) { sa[r] -= dl; sb[r] -= dl; S.o0[r] *= f; S.o1[r] *= f; }
    }
    float l0 = 0.f, l1 = 0.f, l2 = 0.f, l3 = 0.f;
#pragma unroll
    for (int r = 0; r < 16; r += 2) { sa[r] = __builtin_amdgcn_exp2f(sa[r]); sa[r + 1] = __builtin_amdgcn_exp2f(sa[r + 1]); sb[r] = __builtin_amdgcn_exp2f(sb[r]); sb[r + 1] = __builtin_amdgcn_exp2f(sb[r + 1]);
        l0 += sa[r]; l1 += sa[r + 1]; l2 += sb[r]; l3 += sb[r + 1]; }
    S.l += (l0 + l1) + (l2 + l3);
    u32x4 pa0, pa1, pb0, pb1;
    pa0.x = pk2(sa[0], sa[1]); pa0.y = pk2(sa[2], sa[3]); pa0.z = pk2(sa[4], sa[5]); pa0.w = pk2(sa[6], sa[7]);
    pa1.x = pk2(sa[8], sa[9]); pa1.y = pk2(sa[10], sa[11]); pa1.z = pk2(sa[12], sa[13]); pa1.w = pk2(sa[14], sa[15]);
    pb0.x = pk2(sb[0], sb[1]); pb0.y = pk2(sb[2], sb[3]); pb0.z = pk2(sb[4], sb[5]); pb0.w = pk2(sb[6], sb[7]);
    pb1.x = pk2(sb[8], sb[9]); pb1.y = pk2(sb[10], sb[11]); pb1.z = pk2(sb[12], sb[13]); pb1.w = pk2(sb[14], sb[15]);
    asm volatile("s_waitcnt lgkmcnt(0)" ::: "memory");
    __builtin_amdgcn_sched_barrier(0);
#define ATT_VF(i) (bf16x8){vlo[i][0], vlo[i][1], vlo[i][2], vlo[i][3], vhi[i][0], vhi[i][1], vhi[i][2], vhi[i][3]}
#define ATT_PF(x) __builtin_bit_cast(bf16x8, x)
    S.o0 = __builtin_amdgcn_mfma_f32_32x32x16_bf16(ATT_VF(0), ATT_PF(pa0), S.o0, 0, 0, 0);
    S.o1 = __builtin_amdgcn_mfma_f32_32x32x16_bf16(ATT_VF(2), ATT_PF(pa0), S.o1, 0, 0, 0);
    S.o0 = __builtin_amdgcn_mfma_f32_32x32x16_bf16(ATT_VF(1), ATT_PF(pa1), S.o0, 0, 0, 0);
    S.o1 = __builtin_amdgcn_mfma_f32_32x32x16_bf16(ATT_VF(3), ATT_PF(pa1), S.o1, 0, 0, 0);
    S.o0 = __builtin_amdgcn_mfma_f32_32x32x16_bf16(ATT_VF(4), ATT_PF(pb0), S.o0, 0, 0, 0);
    S.o1 = __builtin_amdgcn_mfma_f32_32x32x16_bf16(ATT_VF(6), ATT_PF(pb0), S.o1, 0, 0, 0);
    S.o0 = __builtin_amdgcn_mfma_f32_32x32x16_bf16(ATT_VF(5), ATT_PF(pb1), S.o0, 0, 0, 0);
    S.o1 = __builtin_amdgcn_mfma_f32_32x32x16_bf16(ATT_VF(7), ATT_PF(pb1), S.o1, 0, 0, 0);
#undef ATT_VF
#undef ATT_PF
}
__device__ __forceinline__ unsigned v_lane_off(int lane) { return (unsigned)((4 * (lane >> 5) + ((lane & 15) >> 2)) * 64 + ((lane >> 4) & 1) * 32 + (lane & 3) * 8); }

__device__ __forceinline__ void finish(St& S, bf16_t* Yrow, const bf16_t* __restrict__ Grow, LAS unsigned char* ostage, int lane) {
    const int r32 = lane & 31, hi = lane >> 5;
    const float inv = 1.0f / xhalf_sum(S.l);
#pragma unroll
    for (int db = 0; db < 2; ++db)
#pragma unroll
        for (int g = 0; g < 4; ++g) {
            f32x4 v;
#pragma unroll
            for (int e2 = 0; e2 < 4; ++e2) v[e2] = (db ? S.o1[4 * g + e2] : S.o0[4 * g + e2]) * inv;
            *(LAS f32x4*)(ostage + r32 * 272 + (32 * db + 8 * g + 4 * hi) * 4) = v;
        }
    asm volatile("s_waitcnt lgkmcnt(0)" ::: "memory");
#pragma unroll
    for (int i = 0; i < 4; ++i) {
        const int row = i * 8 + (lane >> 3), c8 = lane & 7;
        const f32x4 a = *(const LAS f32x4*)(ostage + row * 272 + c8 * 32), b = *(const LAS f32x4*)(ostage + row * 272 + c8 * 32 + 16);
        const u32x4 gw = *(const u32x4*)(Grow + row * 64 + c8 * 8);
        u32x4 w;
        w.x = pk2(a[0] * bf_lo(gw.x), a[1] * bf_hi(gw.x)); w.y = pk2(a[2] * bf_lo(gw.y), a[3] * bf_hi(gw.y));
        w.z = pk2(b[0] * bf_lo(gw.z), b[1] * bf_hi(gw.z)); w.w = pk2(b[2] * bf_lo(gw.w), b[3] * bf_hi(gw.w));
        *(u32x4*)(Yrow + (size_t)row * 1024 + c8 * 8) = w;
    }
    asm volatile("s_waitcnt lgkmcnt(0)" ::: "memory");
}

__device__ __forceinline__ void glds16(const void* gsrc, unsigned lds_dst) { unsigned keep;
    asm volatile("s_mov_b32 %0, m0\n\ts_mov_b32 m0, %2\n\ts_nop 0\n\tglobal_load_lds_dwordx4 %1, off\n\ts_mov_b32 m0, %0" : "=&s"(keep) : "v"(gsrc), "s"(lds_dst) : "memory"); }

template <int MODE>
__device__ __forceinline__ void super_unit(const bf16_t* __restrict__ Qrow, const bf16_t* __restrict__ Kb, const bf16_t* __restrict__ Vb, int T0, int T1, int t_lo, int t_hi, int qpos0,
                                           const LAS float* tab, bf16_t* Yrow, const bf16_t* __restrict__ Grow, LAS unsigned char* ring, int tid, int lane) {
    asm volatile("" : "+v"(tid)); lane = tid & 63;
    const int r32 = lane & 31, hi = lane >> 5;
    const int w = __builtin_amdgcn_readfirstlane(tid >> 6);
    bf16x8 qf[4];
#pragma unroll
    for (int d0 = 0; d0 < 4; ++d0) qf[d0] = *(const bf16x8*)(Qrow + r32 * 64 + d0 * 16 + hi * 8);
    const int kkey = 8 * w + (lane >> 3), kch = (lane & 7) ^ ((kkey >> 1) & 7);
    const int vkey = 8 * w + ((lane >> 2) & 7), vch = 4 * ((lane >> 5) & 1) + (lane & 3);
    const bf16_t* kg = Kb + kkey * 64 + kch * 8;
    const bf16_t* vg = Vb + vkey * 64 + vch * 8;
    const unsigned ring0 = (unsigned)(unsigned long)ring;
    const unsigned kdst = (unsigned)__builtin_amdgcn_readfirstlane(ring0 + w * 1024), vdst = kdst + 8192;
    const float cq = (MODE == 1) ? tab[qpos0 + r32] : 0.f;
    const float cfar = (MODE == 0) ? tab[256] : 0.f;
    const unsigned vl = v_lane_off(lane);
    St S; st_init(S);
    asm volatile("" :: "v"(qf[0]), "v"(qf[1]), "v"(qf[2]), "v"(qf[3]));
    int s0 = 0, s1 = 16384, s2 = 32768;
    glds16(kg + (size_t)T0 * 4096, kdst + s0); glds16(vg + (size_t)T0 * 4096, vdst + s0);
    if (T0 + 1 < T1) { glds16(kg + (size_t)(T0 + 1) * 4096, kdst + s1); glds16(vg + (size_t)(T0 + 1) * 4096, vdst + s1);
                       asm volatile("s_waitcnt vmcnt(2) lgkmcnt(0)\n\ts_barrier" ::: "memory"); }
    else             { asm volatile("s_waitcnt vmcnt(0) lgkmcnt(0)\n\ts_barrier" ::: "memory"); }
    for (int t = T0; t < T1; ++t) {
        const bool more = (t + 2 < T1);
        if (more) { glds16(kg + (size_t)(t + 2) * 4096, kdst + s2); glds16(vg + (size_t)(t + 2) * 4096, vdst + s2); }
        LAS unsigned char* buf = ring + s0;
        if (t >= t_lo && t < t_hi)
            step64<MODE>(S, qf, t, qpos0, t == t_hi - 1, t == t_lo, cq, cfar, tab, buf, (unsigned)(unsigned long)(buf + 8192) + vl, r32, hi);
        if (more) asm volatile("s_waitcnt vmcnt(2) lgkmcnt(0)\n\ts_barrier" ::: "memory");
        else      asm volatile("s_waitcnt vmcnt(0) lgkmcnt(0)\n\ts_barrier" ::: "memory");
        const int sn = s0; s0 = s1; s1 = s2; s2 = sn;
    }
    finish(S, Yrow, Grow, ring + 49152 + w * 8704, lane);
}

template <int MODE>
__device__ __forceinline__ void split_unit(const bf16_t* __restrict__ Qrow, const bf16_t* __restrict__ Kb, const bf16_t* __restrict__ Vb, int kb0, int kb1, int kdiag, int qpos0,
                                           const LAS float* tab, bf16_t* Yrow, const bf16_t* __restrict__ Grow, LAS unsigned char* stage0, int wave, int lane) {
    asm volatile("" : "+v"(lane));
    const int r32 = lane & 31, hi = lane >> 5;
    LAS unsigned char* st = stage0 + wave * 8704;
    bf16x8 qf[4];
#pragma unroll
    for (int d0 = 0; d0 < 4; ++d0) qf[d0] = *(const bf16x8*)(Qrow + r32 * 64 + d0 * 16 + hi * 8);
    const int skey = lane >> 3, sch = lane & 7;
    const int kwA = skey * 128 + ((sch ^ (skey >> 1)) << 4), kwB = skey * 128 + ((sch ^ ((skey >> 1) + 4)) << 4);
    const int vw0 = 4096 + (sch >> 2) * 512 + skey * 64 + (sch & 3) * 16;
    const bf16_t* kg = Kb + lane * 8;
    const bf16_t* vg = Vb + lane * 8;
    const unsigned vaddr = (unsigned)(unsigned long)(st + 4096) + v_lane_off(lane);
    u32x4 kr[4], vr[4];
#pragma unroll
    for (int i = 0; i < 4; ++i) { kr[i] = *(const u32x4*)(kg + (size_t)(kb0 * 32 + 8 * i) * 64); vr[i] = *(const u32x4*)(vg + (size_t)(kb0 * 32 + 8 * i) * 64); }
    const float cq = (MODE == 1) ? tab[qpos0 + r32] : 0.f;
    const float cfar = (MODE == 0) ? tab[256] : 0.f;
    St S; st_init(S);
    asm volatile("" :: "v"(qf[0]), "v"(qf[1]), "v"(qf[2]), "v"(qf[3]));
    for (int kb = kb0; kb < kb1; ++kb) {
#pragma unroll
        for (int i = 0; i < 4; ++i) { *(LAS u32x4*)(st + ((i & 1) ? kwB : kwA) + i * 1024) = kr[i]; *(LAS u32x4*)(st + vw0 + i * 1024) = vr[i]; }
        if (kb + 1 < kb1) {
#pragma unroll
            for (int i = 0; i < 4; ++i) { kr[i] = *(const u32x4*)(kg + (size_t)((kb + 1) * 32 + 8 * i) * 64); vr[i] = *(const u32x4*)(vg + (size_t)((kb + 1) * 32 + 8 * i) * 64); }
        }
        step<MODE>(S, qf, kb, qpos0, kb == kdiag, kb == kb0, cq, cfar, tab, st, vaddr, r32, hi);
    }
    LAS float* part = (LAS float*)st;
    const float lt = xhalf_sum(S.l);
    part[0 * 64 + lane] = S.m; part[1 * 64 + lane] = lt;
#pragma unroll
    for (int r = 0; r < 16; ++r) { part[(2 + r) * 64 + lane] = S.o0[r]; part[(18 + r) * 64 + lane] = S.o1[r]; }
    __syncthreads();
    {
        const int db = wave & 1, g = wave >> 1;
        float mw[8]; float M = -3.0e38f;
#pragma unroll
        for (int w = 0; w < 8; ++w) { mw[w] = ((const LAS float*)(stage0 + w * 8704))[lane]; M = fmaxf(M, mw[w]); }
        float L = 0.f, a0 = 0.f, a1 = 0.f, a2 = 0.f, a3 = 0.f;
#pragma unroll
        for (int w = 0; w < 8; ++w) {
            const LAS float* pw = (const LAS float*)(stage0 + w * 8704);
            const float sc = __builtin_amdgcn_exp2f(mw[w] - M);
            L += sc * pw[64 + lane];
            const int base = (2 + 16 * db + 4 * g) * 64 + lane;
            a0 += sc * pw[base]; a1 += sc * pw[base + 64]; a2 += sc * pw[base + 128]; a3 += sc * pw[base + 192];
        }
        const float inv = 1.0f / L;
        const int d = 32 * db + 8 * g + 4 * hi;
        const u32x2 gw2 = *(const u32x2*)(Grow + r32 * 64 + d);
        u32x2 wv; wv.x = pk2(a0 * inv * bf_lo(gw2.x), a1 * inv * bf_hi(gw2.x)); wv.y = pk2(a2 * inv * bf_lo(gw2.y), a3 * inv * bf_hi(gw2.y));
        *(u32x2*)(Yrow + (size_t)r32 * 1024 + d) = wv;
    }
    __syncthreads();
}
}

__device__ __forceinline__ void phase2(const Params& P, LAS unsigned char* lds, int tid, int lane, int wave) {
    LAS float* c2p = (LAS float*)(lds);
    LAS float* c2s = (LAS float*)(lds + 8192);
    LAS float* rb2 = (LAS float*)(lds + 8192 + 8448);
    LAS unsigned char* work = lds + 18432;
    for (int vb = blockIdx.x; vb < 256; vb += gridDim.x) {
        const int b = vb >> 3, h = vb & 7;
        __syncthreads();
        {
            const float* C2P = (const float*)(P.ws + WS_C2P); const float* C2S = (const float*)(P.ws + WS_C2S);
            for (int i = tid; i < 2048; i += 512) c2p[i] = C2P[(size_t)vb * 2048 + i];
            if (vb < 64) for (int i = tid; i < LBS_LEN; i += 512) c2s[i] = C2S[(size_t)vb * LBS_LEN + i];
            for (int i = tid; i < NREL; i += 512) rb2[i] = P.relb[h * NREL + i] * LOG2E;
        }
        __syncthreads();
        if (vb < 128) {
            const int mode = vb < 64, bs = (vb & 63) >> 3;
            const size_t qrow = (size_t)MP + bs * NST;
            const int L = mode ? LBS_LEN : LAS_LEN, nb = L / 32;
            const size_t kvo = (size_t)(bs * 8 + h) * L * 64;
            const size_t qgo = ((size_t)(32 * 8 + h) * 2048 + bs * NST) * 64;
            const int kb0 = (wave * nb) >> 3, kb1 = ((wave + 1) * nb) >> 3;
            const bf16_t* Qrow = (const bf16_t*)(P.ws + WS_SEG + (size_t)(mode ? 4 : 0) * SEG_STRIDE) + qgo;
            const bf16_t* Grow = (const bf16_t*)(P.ws + WS_SEG + (size_t)(mode ? 7 : 3) * SEG_STRIDE) + qgo;
            bf16_t* Yrow = (bf16_t*)(P.ws + WS_H) + qrow * 1024 + (mode ? 512 : 0) + h * 64;
            if (mode) att::split_unit<1>(Qrow, (const bf16_t*)(P.ws + WS_KBS) + kvo, (const bf16_t*)(P.ws + WS_VBS) + kvo, kb0, kb1, nb - 1, PAST, c2s, Yrow, Grow, work, wave, lane);
            else      att::split_unit<0>(Qrow, (const bf16_t*)(P.ws + WS_KAS) + kvo, (const bf16_t*)(P.ws + WS_VAS) + kvo, kb0, kb1, -1, LAC, rb2, Yrow, Grow, work, wave, lane);
        }
        for (int it = 0; it < 16; ++it) {
            const int mode = it < 8, u = it & 7;
            const int hc = 8 * u + wave;
            const size_t qrow = (size_t)b * SEQ + hc * 32;
            const size_t ho = (size_t)(b * 8 + h) * 2048 * 64;
            const bf16_t* Qrow = (const bf16_t*)(P.ws + WS_SEG + (size_t)(mode ? 4 : 0) * SEG_STRIDE) + ho + (size_t)hc * 32 * 64;
            const bf16_t* Grow = (const bf16_t*)(P.ws + WS_SEG + (size_t)(mode ? 7 : 3) * SEG_STRIDE) + ho + (size_t)hc * 32 * 64;
            const bf16_t* Kb = (const bf16_t*)(P.ws + WS_SEG + (size_t)(mode ? 5 : 1) * SEG_STRIDE) + ho;
            const bf16_t* Vb = (const bf16_t*)(P.ws + WS_SEG + (size_t)(mode ? 6 : 2) * SEG_STRIDE) + ho;
            bf16_t* Yrow = (bf16_t*)(P.ws + WS_H) + qrow * 1024 + (mode ? 512 : 0) + h * 64;
            if (mode) {
                att::super_unit<1>(Qrow, Kb, Vb, 0, 4 * u + 4, 0, (hc >> 1) + 1, hc * 32, c2p, Yrow, Grow, work, tid, lane);
            } else {
                const int n = hc >> 1, lo = (n - 8) < 0 ? 0 : (n - 8), t0 = (4 * u - 8) < 0 ? 0 : (4 * u - 8);
                att::super_unit<0>(Qrow, Kb, Vb, t0, 4 * u + 4, lo, n + 1, hc * 32, rb2, Yrow, Grow, work, tid, lane);
            }
        }
    }
}

__device__ __forceinline__ void phase4(const Params& P, int lane, int wave) {
    const int gw = blockIdx.x * 8 + wave, NGW = gridDim.x * 8;
    const bf16_t* mo = (const bf16_t*)(P.ws + WS_SEG);
    f32x4 g4[4];
#pragma unroll
    for (int j = 0; j < 4; ++j) g4[j] = *(const f32x4*)(P.fgain + 4 * lane + 256 * j);
    f32x4 v[4]; u32x2 mv[4];
    int m = gw;
    if (m < MT) {
        const float* xrow = (m < MP) ? P.xp + (size_t)m * 1024 : P.xs + (size_t)(m - MP) * 1024;
#pragma unroll
        for (int j = 0; j < 4; ++j) { v[j] = *(const f32x4*)(xrow + 4 * lane + 256 * j); mv[j] = *(const u32x2*)(mo + (size_t)m * 1024 + 4 * lane + 256 * j); }
    }
    for (; m < MT; m += NGW) {
        f32x4 r[4]; float ss = 0.f;
#pragma unroll
        for (int j = 0; j < 4; ++j) {
            r[j][0] = v[j][0] + bf_lo(mv[j].x); r[j][1] = v[j][1] + bf_hi(mv[j].x); r[j][2] = v[j][2] + bf_lo(mv[j].y); r[j][3] = v[j][3] + bf_hi(mv[j].y);
            ss += (r[j][0] * r[j][0] + r[j][1] * r[j][1]) + (r[j][2] * r[j][2] + r[j][3] * r[j][3]);
        }
        const int mn = m + NGW;
        if (mn < MT) {
            const float* xrow = (mn < MP) ? P.xp + (size_t)mn * 1024 : P.xs + (size_t)(mn - MP) * 1024;
#pragma unroll
            for (int j = 0; j < 4; ++j) { v[j] = *(const f32x4*)(xrow + 4 * lane + 256 * j); mv[j] = *(const u32x2*)(mo + (size_t)mn * 1024 + 4 * lane + 256 * j); }
        }
        ss = wave_sum(ss);
        const float rstd = 1.0f / sqrtf(ss * (1.0f / 1024.0f) + RMS_EPS);
        float* row = P.out + (size_t)m * 1024;
#pragma unroll
        for (int j = 0; j < 4; ++j) *(f32x4*)(row + 4 * lane + 256 * j) = r[j] * rstd * g4[j];
    }
}

#define LOAD_PARAMS() const Params& P = Parg
__device__ __forceinline__ int my_tid() { int t = (int)threadIdx.x; asm volatile("" : "+v"(t)); return t; }
#define MY_TID() my_tid()
__global__ void __launch_bounds__(512, 2) hymba_fwd(Params Parg) {
    extern __shared__ __attribute__((aligned(16))) unsigned char lds_raw[];
    LAS unsigned char* lds = (LAS unsigned char*)lds_raw;
    cg::grid_group grid = cg::this_grid();
    const int wave = __builtin_amdgcn_readfirstlane((int)threadIdx.x >> 6);

    {   LOAD_PARAMS(); const int tid = MY_TID();
        phase0(P, lds, tid, tid & 63, wave); }
    grid.sync();

    {
        LOAD_PARAMS(); const int tid = MY_TID();
        LAS float* red = (LAS float*)(lds);
        for (int u = blockIdx.x; u < 256; u += gridDim.x) {
            const int b = u >> 3, h = u & 7;
            const float* src = P.out + O_LFP + ((size_t)b * SEQ) * 8 + h;
            block_cumsum<4>(SEQ, [&](int t) { return src[(size_t)t * 8]; }, (float*)(P.ws + WS_C2P) + (size_t)u * 2048, red, tid);
        }
        for (int u = blockIdx.x; u < 64; u += gridDim.x) {
            const int b = u >> 3, h = u & 7;
            const float* src0 = P.cblf + ((size_t)b * PAST) * 8 + h;
            const float* src1 = P.out + O_LFS + ((size_t)b * NST) * 8 + h;
            block_cumsum<5>(LBS_LEN, [&](int t) { return t < PAST ? src0[(size_t)t * 8] : src1[(size_t)(t - PAST) * 8]; }, (float*)(P.ws + WS_C2S) + (size_t)u * LBS_LEN, red, tid);
        }
        for (int c = blockIdx.x; c < 256; c += gridDim.x) {
            const int rg = c & 3, cg = c >> 2, seg = cg >> 3, head = cg & 7, kind = seg & 3, grp = seg >> 2;
            const bool kv = (kind == 1 || kind == 2);
            bf16_t* bdst; int L, Pn;
            if (kv) { bdst = (bf16_t*)(P.ws + (grp == 0 ? (kind == 1 ? WS_KAS : WS_VAS) : (kind == 1 ? WS_KBS : WS_VBS))); L = grp == 0 ? LAS_LEN : LBS_LEN; Pn = grp == 0 ? LAC : PAST; }
            else    { bdst = (bf16_t*)(P.ws + WS_SEG + (size_t)seg * SEG_STRIDE); L = 0; Pn = 0; }
            float* fdst = kv ? P.out + (grp == 0 ? (kind == 1 ? O_AKS : O_AVS) : (kind == 1 ? O_BKS : O_BVS)) : nullptr;
            mini_gemm64((const bf16_t*)(P.ws + WS_H) + (size_t)(MP + rg * 64) * 1024, (const bf16_t*)(P.ws + WS_WIN) + (size_t)cg * 64 * 1024, wave, tid & 63,
                [&](int row, int col, f32x4 v) {
                    const int r = rg * 64 + row;
                    if (fdst) *(f32x4*)(fdst + (size_t)r * 512 + head * 64 + col) = v;
                    if (kind == 0) v = v * QSCALE;
                    else if (kind == 3) {
#pragma unroll
                        for (int e = 0; e < 4; ++e) v[e] = v[e] * __builtin_amdgcn_rcpf(1.0f + __builtin_amdgcn_exp2f(-LOG2E * v[e]));
                    }
                    const size_t bidx = kv ? (((size_t)((r >> 5) * 8 + head) * L + Pn + (r & 31)) * 64 + col) : (((size_t)(32 * 8 + head) * 2048 + r) * 64 + col);
                    u32x2 w; w.x = pk2(v[0], v[1]); w.y = pk2(v[2], v[3]);
                    *(u32x2*)(bdst + bidx) = w;
                });
        }
        pg8::Gemm g{(const bf16_t*)(P.ws + WS_H), (const bf16_t*)(P.ws + WS_WIN), MP, 4096, 1024};
        pg8::StaticOrder S; S.init(MP, 4096, (int)gridDim.x, (int)blockIdx.x);
        EpiProj E{P.ws, P.out};
        pg8::gemm_phase<EpiProj, pg8::StaticOrder, true, true>(lds, g, S, E, tid);
    }
    grid.sync();

    {   LOAD_PARAMS(); const int tid = MY_TID();
        phase2(P, lds, tid, tid & 63, wave); }
    grid.sync();

    {
        LOAD_PARAMS(); const int tid = MY_TID();
        for (int c = blockIdx.x; c < 64; c += gridDim.x) {
            const int rg = c & 3, cg = c >> 2;
            bf16_t* mo = (bf16_t*)(P.ws + WS_SEG);
            mini_gemm64((const bf16_t*)(P.ws + WS_H) + (size_t)(MP + rg * 64) * 1024, (const bf16_t*)(P.ws + WS_WOUT) + (size_t)cg * 64 * 1024, wave, tid & 63,
                [&](int row, int col, f32x4 v) {
                    u32x2 w; w.x = pk2(v[0], v[1]); w.y = pk2(v[2], v[3]);
                    *(u32x2*)(mo + (size_t)(MP + rg * 64 + row) * 1024 + cg * 64 + col) = w;
                });
        }
        pg8::Gemm g{(const bf16_t*)(P.ws + WS_H), (const bf16_t*)(P.ws + WS_WOUT), MP, 1024, 1024};
        pg8::StaticOrder S; S.init(MP, 1024, (int)gridDim.x, (int)blockIdx.x);
        EpiOut E{(bf16_t*)(P.ws + WS_SEG)};
        pg8::gemm_phase<EpiOut, pg8::StaticOrder, true, true>(lds, g, S, E, tid);
    }
    grid.sync();

    {   LOAD_PARAMS(); const int tid = MY_TID();
        phase4(P, (int)__builtin_amdgcn_mbcnt_hi(~0u, __builtin_amdgcn_mbcnt_lo(~0u, 0u)), wave); }
}

extern "C" void kernel_launch(void* const* d_in, const int* in_sizes, int n_in, void* d_out, int out_size, void* d_ws, size_t ws_size, hipStream_t stream) {
    static int grid = 0;
    if (grid == 0) {
        if (n_in != 13 || in_sizes[0] != MP * 1024 || (size_t)out_size != O_END || ws_size < WS_END) {
            fprintf(stderr, "kernel_launch: shape mismatch: n_in %d in0 %d out %d (want %zu) ws %zu (want %zu)\n", n_in, n_in > 0 ? in_sizes[0] : -1, out_size, (size_t)O_END, ws_size, (size_t)WS_END);
            grid = -1; return;
        }
        int dev = 0, cus = 0, per_cu = 0;
        hipGetDevice(&dev);
        hipDeviceGetAttribute(&cus, hipDeviceAttributeMultiprocessorCount, dev);
        hipFuncSetAttribute((const void*)hymba_fwd, hipFuncAttributeMaxDynamicSharedMemorySize, LDS_BYTES);
        hipOccupancyMaxActiveBlocksPerMultiprocessor(&per_cu, (const void*)hymba_fwd, 512, LDS_BYTES);
        if (per_cu < 1 || cus < 1) { fprintf(stderr, "kernel_launch: occupancy query gave %d blocks/CU on %d CUs\n", per_cu, cus); grid = -1; return; }
        grid = cus * per_cu;
        if (grid > 256) grid = 256;
    }
    if (grid < 0) return;
    Params p{};
    p.xp = (const float*)d_in[0]; p.xs = (const float*)d_in[1]; p.cak = (const float*)d_in[2]; p.cav = (const float*)d_in[3]; p.cbk = (const float*)d_in[4]; p.cbv = (const float*)d_in[5];
    p.cblf = (const float*)d_in[6]; p.gain = (const float*)d_in[7]; p.win = (const float*)d_in[8]; p.bfg = (const float*)d_in[9]; p.relb = (const float*)d_in[10]; p.wout = (const float*)d_in[11];
    p.fgain = (const float*)d_in[12]; p.out = (float*)d_out; p.ws = (unsigned char*)d_ws;
    void* args[] = {&p};
    hipError_t e = hipLaunchCooperativeKernel((const void*)hymba_fwd, dim3(grid), dim3(512), args, LDS_BYTES, stream);
    if (e != hipSuccess) fprintf(stderr, "cooperative launch failed: %s (grid %d)\n", hipGetErrorString(e), grid);
}
```

```cpp
#include <hip/hip_runtime.h>
#include <hip/hip_cooperative_groups.h>
#include <cstdio>
#include <cstdint>
namespace cg = cooperative_groups;
namespace pg8 {
#define PG8_LAS __attribute__((address_space(3)))
typedef unsigned short bf16_t;
typedef short bf16x8 __attribute__((ext_vector_type(8)));
typedef float f32x4 __attribute__((ext_vector_type(4)));
typedef unsigned u32x4 __attribute__((ext_vector_type(4)));
constexpr int BM = 256, BK = 64, HALF = 128, HTB = HALF * BK * 2  , STAGE_BYTES = 8 * HTB, NXCD = 8, WGM = 8;

__host__ __device__ __forceinline__ int lds_byte(int r, int c) { const int st = (r >> 4) * 2 + (c >> 5), rr = r & 15, cc = c & 31, ob = rr * 64 + cc * 2; return st * 1024 + (ob ^ (((ob >> 9) & 1) << 5)); }
__host__ __device__ __forceinline__ void stage_rc(int b, int& R, int& C) { const int st = b / 1024, sb = b % 1024, swz = sb ^ (((sb >> 9) & 1) << 5); R = (st >> 1) * 16 + swz / 64; C = (st & 1) * 32 + (swz % 64) / 2; }
__host__ __device__ __forceinline__ int perm32(int rho) { const int n = rho >> 4, i = rho & 15; return 8 * (i >> 2) + 4 * n + (i & 3); }

struct Unit { int pm, pn; };
struct Gemm { const bf16_t* A; const bf16_t* Bt; int M, N, K; };

struct StaticOrder {
    int nM, nN, nwg, G, c;
    __host__ __device__ void init(int M, int N, int G_, int c_) { nM = M / BM; nN = N / BM; nwg = nM * nN; G = G_; c = c_; }
    __host__ __device__ bool next(int i, Unit& u) const {
        const long L = (long)i * G + c; if (L >= nwg) return false;
        int wgid = (int)L; { const int q = nwg / NXCD, r = nwg % NXCD, xcd = wgid % NXCD, off = wgid / NXCD; wgid = (xcd < r ? xcd * (q + 1) : r * (q + 1) + (xcd - r) * q) + off; }
        const int nig = WGM * nN, gid = wgid / nig, fm = gid * WGM, gsz = (nM - fm) < WGM ? (nM - fm) : WGM;
        u.pm = fm + ((wgid % nig) % gsz); u.pn = (wgid % nig) / gsz; return true;
    }
    __device__ __forceinline__ void a_ready(const Unit&) const {}
    __device__ __forceinline__ void done(const Unit&) const {}
};
__device__ __forceinline__ unsigned cvt_pk_bf16(float lo, float hi) { unsigned r; asm volatile("v_cvt_pk_bf16_f32 %0, %1, %2" : "=v"(r) : "v"(lo), "v"(hi)); return r; }
typedef float f32x2 __attribute__((ext_vector_type(2)));
template <class Epi, class Sched, bool ALIGN_EPI = false, bool SP2 = false>
__device__ __forceinline__ void gemm_phase(PG8_LAS unsigned char* lds, const Gemm g, const Sched& S, const Epi& E, const int tid) {
    const int wid = __builtin_amdgcn_readfirstlane(tid >> 6), lane = tid & 63, wr = wid >> 2, wc = wid & 3, fr = lane & 15, fq = lane >> 4;
    const int K = g.K, nt = K / BK;
    unsigned voffA[2], voffB[2];
#pragma unroll
    for (int i = 0; i < 2; ++i) { int R, C; stage_rc(tid * 16 + i * 8192, R, C); const int Rb = Epi::PERM ? ((R & ~31) + perm32(R & 31)) : R;
        voffA[i] = (unsigned)(R * K + C) * 2u; voffB[i] = (unsigned)(Rb * K + C) * 2u; }
    const size_t kstep = (size_t)(BK * 2);
    const size_t hstep = (size_t)HALF * K * 2;
    const size_t tstep = 2 * hstep;
    const unsigned ldsw = (unsigned)wid * 1024u;
    const int aoff = lds_byte(wr * 64 + fr, fq * 8), boff = lds_byte(wc * 32 + fr, fq * 8);
#define PG8_SA(b, h) (((b) * 2 + (h)) * HTB)
#define PG8_SB(b, h) ((4 + (b) * 2 + (h)) * HTB)
#define PG8_STAGE(bufoff, gbase, voff) do { _Pragma("unroll") for (int _i = 0; _i < 2; ++_i) \
        __builtin_amdgcn_global_load_lds((const unsigned*)((const char*)(gbase) + (voff)[_i]), (PG8_LAS unsigned*)(lds + (bufoff) + ldsw + _i * 8192), 16, 0, 0); } while (0)
#define PG8_LDA(dst, b, h) do { _Pragma("unroll") for (int m = 0; m < 4; ++m) _Pragma("unroll") for (int k = 0; k < 2; ++k) dst[m][k] = *(const PG8_LAS bf16x8*)(lds + PG8_SA(b, h) + aoff + m * 2048 + k * 1024); } while (0)
#define PG8_LDB(dst, b, h) do { _Pragma("unroll") for (int n = 0; n < 2; ++n) _Pragma("unroll") for (int k = 0; k < 2; ++k) dst[n][k] = *(const PG8_LAS bf16x8*)(lds + PG8_SB(b, h) + boff + n * 2048 + k * 1024); } while (0)
#define PG8_MMA(ai, bj, At, Bt) do { __builtin_amdgcn_s_setprio(1); _Pragma("unroll") for (int m = 0; m < 4; ++m) _Pragma("unroll") for (int n = 0; n < 2; ++n) _Pragma("unroll") for (int k = 0; k < 2; ++k) \
        acc[ai][bj][m][n] = __builtin_amdgcn_mfma_f32_16x16x32_bf16(Bt[n][k], At[m][k], acc[ai][bj][m][n], 0, 0, 0); __builtin_amdgcn_s_setprio(0); } while (0)
#define PG8_WAIT_V(n) asm volatile("s_waitcnt vmcnt(" #n ")" ::: "memory")
#define PG8_WAIT_L(n) asm volatile("s_waitcnt lgkmcnt(" #n ")" ::: "memory")
#define PG8_BAR __builtin_amdgcn_s_barrier()
#define PG8_SCHED __builtin_amdgcn_sched_barrier(0)
    Unit cur, nxt; int ui = 0;
    if (!S.next(0, cur)) return;
    f32x4 acc[2][2][4][2];
#pragma unroll
    for (int a = 0; a < 2; ++a)
#pragma unroll
        for (int b = 0; b < 2; ++b)
#pragma unroll
            for (int m = 0; m < 4; ++m)
#pragma unroll
                for (int n = 0; n < 2; ++n) acc[a][b][m][n] = (f32x4){0.f, 0.f, 0.f, 0.f};
    bf16x8 At[4][2], B0[2][2], B1[2][2];
    const char* cA = (const char*)g.A + (size_t)cur.pm * tstep; const char* cB = (const char*)g.Bt + (size_t)cur.pn * tstep;
    S.a_ready(cur);
    if constexpr (SP2) {
        PG8_STAGE(PG8_SB(0, 0), cB, voffB); PG8_STAGE(PG8_SB(0, 1), cB + hstep, voffB); PG8_STAGE(PG8_SA(0, 0), cA, voffA); PG8_STAGE(PG8_SA(0, 1), cA + hstep, voffA);
        if (wr == 1) PG8_BAR;
        PG8_WAIT_V(2); PG8_BAR;
        PG8_STAGE(PG8_SB(1, 0), cB + kstep, voffB); PG8_STAGE(PG8_SA(1, 0), cA + kstep, voffA); PG8_STAGE(PG8_SB(1, 1), cB + hstep + kstep, voffB);
        PG8_WAIT_V(6); PG8_BAR;
    } else {
        PG8_STAGE(PG8_SB(0, 0), cB, voffB); PG8_STAGE(PG8_SA(0, 0), cA, voffA); PG8_STAGE(PG8_SB(0, 1), cB + hstep, voffB); PG8_STAGE(PG8_SA(0, 1), cA + hstep, voffA);
        if (wr == 1) PG8_BAR;
        PG8_WAIT_V(4); PG8_BAR;
        PG8_STAGE(PG8_SB(1, 0), cB + kstep, voffB); PG8_STAGE(PG8_SA(1, 0), cA + kstep, voffA); PG8_STAGE(PG8_SB(1, 1), cB + hstep + kstep, voffB);
        PG8_WAIT_V(6); PG8_BAR;
    }
    for (;;) {
        const bool has_next = S.next(ui + 1, nxt);
        const char* nA = has_next ? (const char*)g.A + (size_t)nxt.pm * tstep : cA; const char* nB = has_next ? (const char*)g.Bt + (size_t)nxt.pn * tstep : cB;
        for (int t = 0; t < nt; t += 2) {
            const bool last = (t == nt - 2);
            const char* a1 = cA + (size_t)(t + 1) * kstep;
            const char* a2 = last ? nA : cA + (size_t)(t + 2) * kstep; const char* b2 = last ? nB : cB + (size_t)(t + 2) * kstep;
            const char* a3 = a2 + kstep; const char* b3 = b2 + kstep;
            if (last && has_next) S.a_ready(nxt);
            if constexpr (SP2) {
            PG8_LDB(B0, 0, 0); PG8_LDB(B1, 0, 1); PG8_SCHED; PG8_LDA(At, 0, 0); PG8_STAGE(PG8_SA(1, 1), a1 + hstep, voffA);
            PG8_WAIT_V(8); PG8_WAIT_L(0); PG8_BAR; PG8_MMA(0, 0, At, B0); PG8_MMA(0, 1, At, B1); PG8_BAR; PG8_SCHED;
            PG8_LDA(At, 0, 1); PG8_STAGE(PG8_SB(0, 0), b2, voffB); PG8_STAGE(PG8_SB(0, 1), b2 + hstep, voffB); PG8_STAGE(PG8_SA(0, 0), a2, voffA);
            PG8_WAIT_V(8); PG8_WAIT_L(0); PG8_BAR; PG8_MMA(1, 0, At, B0); PG8_MMA(1, 1, At, B1); PG8_BAR; PG8_SCHED;
            PG8_LDB(B0, 1, 0); PG8_LDB(B1, 1, 1); PG8_SCHED; PG8_LDA(At, 1, 0); PG8_STAGE(PG8_SA(0, 1), a2 + hstep, voffA);
            PG8_WAIT_V(8); PG8_WAIT_L(0); PG8_BAR; PG8_MMA(0, 0, At, B0); PG8_MMA(0, 1, At, B1); PG8_BAR; PG8_SCHED;
            PG8_LDA(At, 1, 1); PG8_STAGE(PG8_SB(1, 0), b3, voffB); PG8_STAGE(PG8_SB(1, 1), b3 + hstep, voffB); PG8_STAGE(PG8_SA(1, 0), a3, voffA);
            PG8_WAIT_V(8); PG8_WAIT_L(0); PG8_BAR; PG8_MMA(1, 0, At, B0); PG8_MMA(1, 1, At, B1); PG8_BAR; PG8_SCHED;
            } else {
            PG8_LDB(B0, 0, 0); PG8_SCHED; PG8_LDA(At, 0, 0); PG8_STAGE(PG8_SA(1, 1), a1 + hstep, voffA);
            PG8_WAIT_L(8); PG8_BAR; PG8_WAIT_L(0); PG8_MMA(0, 0, At, B0); PG8_BAR; PG8_SCHED;
            PG8_LDB(B1, 0, 1); PG8_STAGE(PG8_SB(0, 0), b2, voffB);
            PG8_BAR; PG8_WAIT_L(0); PG8_MMA(0, 1, At, B1); PG8_BAR;
            PG8_LDA(At, 0, 1); PG8_STAGE(PG8_SA(0, 0), a2, voffA);
            PG8_BAR; PG8_WAIT_L(0); PG8_MMA(1, 0, At, B0); PG8_BAR; PG8_SCHED;
            PG8_STAGE(PG8_SB(0, 1), b2 + hstep, voffB);
            PG8_WAIT_V(6); PG8_BAR; PG8_MMA(1, 1, At, B1); PG8_BAR;
            PG8_LDB(B0, 1, 0); PG8_SCHED; PG8_LDA(At, 1, 0); PG8_STAGE(PG8_SA(0, 1), a2 + hstep, voffA);
            PG8_WAIT_L(8); PG8_BAR; PG8_WAIT_L(0); PG8_MMA(0, 0, At, B0); PG8_BAR; PG8_SCHED;
            PG8_LDB(B1, 1, 1); PG8_STAGE(PG8_SB(1, 0), b3, voffB);
            PG8_BAR; PG8_WAIT_L(0); PG8_MMA(0, 1, At, B1); PG8_BAR;
            PG8_LDA(At, 1, 1); PG8_STAGE(PG8_SA(1, 0), a3, voffA);
            PG8_BAR; PG8_WAIT_L(0); PG8_MMA(1, 0, At, B0); PG8_BAR; PG8_SCHED;
            PG8_STAGE(PG8_SB(1, 1), b3 + hstep, voffB);
            PG8_WAIT_V(6); PG8_BAR; PG8_MMA(1, 1, At, B1); PG8_BAR;
            }
        }
        if constexpr (ALIGN_EPI) { if (wr == 0) PG8_BAR; }
        if constexpr (!Epi::AFTER_DRAIN) { E(acc, cur, wr, wc, fr, fq); S.done(cur); }
        if (!has_next) break;
#pragma unroll
        for (int a = 0; a < 2; ++a)
#pragma unroll
            for (int b = 0; b < 2; ++b)
#pragma unroll
                for (int m = 0; m < 4; ++m)
#pragma unroll
                    for (int n = 0; n < 2; ++n) acc[a][b][m][n] = (f32x4){0.f, 0.f, 0.f, 0.f};
        cur = nxt; cA = nA; cB = nB; ++ui;
        if constexpr (ALIGN_EPI) { if (wr == 1) PG8_BAR; }
    }
    PG8_WAIT_V(0);
    if constexpr (!ALIGN_EPI) { if (wr == 0) PG8_BAR; }
    PG8_BAR;
    if constexpr (Epi::AFTER_DRAIN) { E.fused(acc, cur, wr, wc, fr, fq, lds, wid, lane); S.done(cur); }
#undef PG8_SA
#undef PG8_SB
#undef PG8_STAGE
#undef PG8_LDA
#undef PG8_LDB
#undef PG8_MMA
#undef PG8_WAIT_V
#undef PG8_WAIT_L
#undef PG8_BAR
#undef PG8_SCHED
}
}

#define LAS __attribute__((address_space(3)))
typedef unsigned short bf16_t;
typedef short bf16x8 __attribute__((ext_vector_type(8)));
typedef short s16x4 __attribute__((ext_vector_type(4)));
typedef float f32x4 __attribute__((ext_vector_type(4)));
typedef float f32x16 __attribute__((ext_vector_type(16)));
typedef unsigned u32x4 __attribute__((ext_vector_type(4)));
typedef unsigned u32x2 __attribute__((ext_vector_type(2)));

constexpr int DM = 1024, NB = 32, SEQ = 2048, MP = NB * SEQ, NSB = 8, NST = 32, MS = NSB * NST, MT = MP + MS;
constexpr int PAST = 2048, LAC = 512, DIN = 4104, NREL = 257;
constexpr int LAS_LEN = LAC + NST  , LBS_LEN = PAST + NST  ;
constexpr float LOG2E = 1.4426950408889634f, QSCALE = 0.125f * LOG2E, RMS_EPS = 1e-6f;

constexpr size_t O_Y = 0;
constexpr size_t O_AKP = (size_t)MT * 1024;
constexpr size_t O_AVP = O_AKP + (size_t)NB * 512 * 512;
constexpr size_t O_BKP = O_AVP + (size_t)NB * 512 * 512;
constexpr size_t O_BVP = O_BKP + (size_t)MP * 512;
constexpr size_t O_LFP = O_BVP + (size_t)MP * 512;
constexpr size_t O_AKS = O_LFP + (size_t)MP * 8;
constexpr size_t O_AVS = O_AKS + (size_t)MS * 512;
constexpr size_t O_BKS = O_AVS + (size_t)MS * 512;
constexpr size_t O_BVS = O_BKS + (size_t)MS * 512;
constexpr size_t O_LFS = O_BVS + (size_t)MS * 512;
constexpr size_t O_END = O_LFS + (size_t)MS * 8;

constexpr size_t MiB = 1u << 20;
constexpr size_t WS_WIN = 0, WS_WOUT = 8 * MiB, WS_C2P = 10 * MiB, WS_C2S = 12 * MiB, WS_PS = 13 * MiB, WS_BAR = 13 * MiB, BAR_BYTES = 16384;
constexpr size_t WS_KAS = 18 * MiB, WS_VAS = 23 * MiB, WS_KBS = 28 * MiB, WS_VBS = 45 * MiB;
constexpr size_t WS_H = 64 * MiB;
constexpr size_t WS_SEG = 200 * MiB, SEG_STRIDE = 66 * MiB;
constexpr size_t WS_END = WS_SEG + 8 * SEG_STRIDE;
static_assert((size_t)33 * 8 * 2048 * 64 * 2 <= SEG_STRIDE && (size_t)MT * 1024 * 2 <= WS_SEG - WS_H && (size_t)MT * 64 <= WS_KAS - WS_PS, "ws map");
static_assert((size_t)NSB * LAS_LEN * 512 * 2 <= 5 * MiB && (size_t)NSB * LBS_LEN * 512 * 2 <= 17 * MiB, "ws map");

constexpr int LDS_BYTES = 147456;

struct Params {
    const float* xp; const float* xs; const float* cak; const float* cav; const float* cbk; const float* cbv; const float* cblf;
    const float* gain; const float* win; const float* bfg; const float* relb; const float* wout; const float* fgain;
    float* out; unsigned char* ws;
};

__device__ __forceinline__ float wave_sum(float v) {
#pragma unroll
    for (int o = 1; o < 64; o <<= 1) v += __shfl_xor(v, o);
    return v;
}
typedef float f32x2_t __attribute__((ext_vector_type(2))); typedef __bf16 bf16x2_t __attribute__((ext_vector_type(2)));
__device__ __forceinline__ unsigned pk2(float lo, float hi) { f32x2_t v = {lo, hi}; bf16x2_t b = __builtin_convertvector(v, bf16x2_t); return __builtin_bit_cast(unsigned, b); }
__device__ __forceinline__ float bf_lo(unsigned w) { return __uint_as_float(w << 16); }
__device__ __forceinline__ float bf_hi(unsigned w) { return __uint_as_float(w & 0xffff0000u); }

struct EpiProj {
    static constexpr bool PERM = true, AFTER_DRAIN = false;
    unsigned char* ws; float* out;
    __device__ __forceinline__ void operator()(const pg8::f32x4 (&acc)[2][2][4][2], const pg8::Unit& u, int wr, int wc, int fr, int fq) const {
        const int seg = u.pn >> 1, kind = seg & 3, grp = seg >> 2;
        const bool smp = (u.pm == MP / 256);
        const bool kv = (kind == 1 || kind == 2);
        const int colw = (u.pn & 1) * 256 + wc * 32 + 8 * fq;
        bf16_t* bbase = (bf16_t*)(ws + WS_SEG + (size_t)seg * SEG_STRIDE);
        int sL = 0, sP = 0;
        if (smp && kv) {
            if (grp == 0) { bbase = (bf16_t*)(ws + (kind == 1 ? WS_KAS : WS_VAS)); sL = LAS_LEN; sP = LAC; }
            else          { bbase = (bf16_t*)(ws + (kind == 1 ? WS_KBS : WS_VBS)); sL = LBS_LEN; sP = PAST; }
        }
        float* fdst = nullptr; unsigned frow0 = 0;
        if (kv) {
            if (smp) { fdst = out + (grp == 0 ? (kind == 1 ? O_AKS : O_AVS) : (kind == 1 ? O_BKS : O_BVS)); }
            else if (grp == 1) { fdst = out + (kind == 1 ? O_BKP : O_BVP); frow0 = (unsigned)u.pm * 256u; }
            else if ((u.pm & 7) >= 6) { fdst = out + (kind == 1 ? O_AKP : O_AVP); frow0 = (unsigned)(u.pm >> 3) * 512u + (unsigned)((u.pm & 7) - 6) * 256u; }
        }
        const int hd0 = (u.pn & 1) * 4 + (wc >> 1), dcol = (wc & 1) * 32 + 8 * fq;
        const unsigned bat = (unsigned)(u.pm >> 3), t0 = (unsigned)(u.pm & 7) * 256u;
#pragma unroll
        for (int ai = 0; ai < 2; ++ai)
#pragma unroll
            for (int m = 0; m < 4; ++m) {
                const int rt = ai * 128 + wr * 64 + m * 16 + fr;
#pragma unroll
                for (int bj = 0; bj < 2; ++bj) {
                    const unsigned head = (unsigned)(hd0 + 2 * bj);
                    const unsigned bidx = sL ? ((((unsigned)(rt >> 5) * 8u + head) * (unsigned)sL + (unsigned)(sP + (rt & 31))) * 64u + (unsigned)dcol)
                                             : (((bat * 8u + head) * 2048u + t0 + (unsigned)rt) * 64u + (unsigned)dcol);
                    pg8::f32x4 v0 = acc[ai][bj][m][0], v1 = acc[ai][bj][m][1];
                    if (fdst) { float* fp = fdst + ((frow0 + (unsigned)rt) * 512u + (unsigned)(colw + bj * 128)); *(pg8::f32x4*)fp = v0; *(pg8::f32x4*)(fp + 4) = v1; }
                    if (kind == 0) { v0 = v0 * QSCALE; v1 = v1 * QSCALE; }
                    else if (kind == 3) {
#pragma unroll
                        for (int e = 0; e < 4; ++e) {
                            v0[e] = v0[e] * __builtin_amdgcn_rcpf(1.0f + __builtin_amdgcn_exp2f(-LOG2E * v0[e]));
                            v1[e] = v1[e] * __builtin_amdgcn_rcpf(1.0f + __builtin_amdgcn_exp2f(-LOG2E * v1[e]));
                        }
                    }
                    pg8::u32x4 w; w.x = pk2(v0[0], v0[1]); w.y = pk2(v0[2], v0[3]); w.z = pk2(v1[0], v1[1]); w.w = pk2(v1[2], v1[3]);
                    *(pg8::u32x4*)(bbase + bidx) = w;
                }
            }
    }
};

struct EpiOut {
    static constexpr bool PERM = true, AFTER_DRAIN = false;
    bf16_t* mo;
    __device__ __forceinline__ void operator()(const pg8::f32x4 (&acc)[2][2][4][2], const pg8::Unit& u, int wr, int wc, int fr, int fq) const {
        const unsigned c0 = (unsigned)(u.pn * 256 + wc * 32 + 8 * fq);
#pragma unroll
        for (int ai = 0; ai < 2; ++ai)
#pragma unroll
            for (int m = 0; m < 4; ++m) {
                const unsigned grow = (unsigned)u.pm * 256u + (unsigned)(ai * 128 + wr * 64 + m * 16 + fr);
#pragma unroll
                for (int bj = 0; bj < 2; ++bj) {
                    const pg8::f32x4 v0 = acc[ai][bj][m][0], v1 = acc[ai][bj][m][1];
                    pg8::u32x4 w; w.x = pk2(v0[0], v0[1]); w.y = pk2(v0[2], v0[3]); w.z = pk2(v1[0], v1[1]); w.w = pk2(v1[2], v1[3]);
                    *(pg8::u32x4*)(mo + (grow * 1024u + c0 + (unsigned)(bj * 128))) = w;
                }
            }
    }
};

template <class F>
__device__ __forceinline__ void mini_gemm64(const bf16_t* __restrict__ A, const bf16_t* __restrict__ Bt, int wave, int lane, F&& epi) {
    const int fr = lane & 15, fq = lane >> 4;
    const bf16_t* ap = A + (size_t)(16 * (wave >> 1) + fr) * 1024 + 8 * fq;
    const bf16_t* b0 = Bt + (size_t)(32 * (wave & 1) + fr) * 1024 + 8 * fq;
    const bf16_t* b1 = b0 + 16 * 1024;
    f32x4 acc0 = {0.f, 0.f, 0.f, 0.f}, acc1 = {0.f, 0.f, 0.f, 0.f};
#pragma unroll 8
    for (int ks = 0; ks < 32; ++ks) {
        const bf16x8 a = *(const bf16x8*)(ap + ks * 32), x0 = *(const bf16x8*)(b0 + ks * 32), x1 = *(const bf16x8*)(b1 + ks * 32);
        acc0 = __builtin_amdgcn_mfma_f32_16x16x32_bf16(x0, a, acc0, 0, 0, 0);
        acc1 = __builtin_amdgcn_mfma_f32_16x16x32_bf16(x1, a, acc1, 0, 0, 0);
    }
    const int row = 16 * (wave >> 1) + fr, col = 32 * (wave & 1) + 4 * fq;
    epi(row, col, acc0); epi(row, col + 16, acc1);
}

__device__ __forceinline__ void p0_transpose_item(const float* W, int ldw, int ncols, int K, bf16_t* WT, LAS float* scr, int item, int lane) {
    const int nblk = ncols / 32, kb = item / nblk, nb = item % nblk, k0 = 64 * kb, n0 = 32 * nb;
#pragma unroll 8
    for (int i = 0; i < 32; ++i) { const int kk = 2 * i + (lane >> 5); scr[kk * 33 + (lane & 31)] = W[(size_t)(k0 + kk) * ldw + n0 + (lane & 31)]; }
    asm volatile("s_waitcnt lgkmcnt(0)" ::: "memory");
    const int c = lane & 7;
#pragma unroll
    for (int j = 0; j < 4; ++j) { const int n = (lane >> 3) + 8 * j; const LAS float* s = scr + (8 * c) * 33 + n;
        u32x4 o; o.x = pk2(s[0 * 33], s[1 * 33]); o.y = pk2(s[2 * 33], s[3 * 33]); o.z = pk2(s[4 * 33], s[5 * 33]); o.w = pk2(s[6 * 33], s[7 * 33]);
        *(u32x4*)(WT + (size_t)(n0 + n) * K + k0 + 8 * c) = o; }
    asm volatile("s_waitcnt lgkmcnt(0)" ::: "memory");
}

__device__ __forceinline__ void conv_chunk(const float* src, bf16_t* dst, int c, int pshift, int L) {
    const int row = c >> 6, col8 = c & 63, b = row >> pshift, pos = row & ((1 << pshift) - 1);
    const f32x4 a = *(const f32x4*)(src + (size_t)c * 8), d = *(const f32x4*)(src + (size_t)c * 8 + 4);
    u32x4 o; o.x = pk2(a[0], a[1]); o.y = pk2(a[2], a[3]); o.z = pk2(d[0], d[1]); o.w = pk2(d[2], d[3]);
    *(u32x4*)(dst + (((size_t)(b * 8 + (col8 >> 3)) * L + pos) * 64 + (col8 & 7) * 8)) = o;
}

__device__ __forceinline__ void phase0(const Params& P, LAS unsigned char* lds, int tid, int lane, int wave) {
    const int G = gridDim.x, gw = blockIdx.x * 8 + wave, NGW = G * 8;
    bf16_t* Win_t = (bf16_t*)(P.ws + WS_WIN); bf16_t* Wout_t = (bf16_t*)(P.ws + WS_WOUT); bf16_t* H = (bf16_t*)(P.ws + WS_H);
    LAS float* wfL = (LAS float*)(lds + 69632);
    for (int i = tid; i < 1024 * 8; i += 512) wfL[i] = P.win[(size_t)(i >> 3) * DIN + 4096 + (i & 7)];
    LAS float* scr = (LAS float*)(lds + wave * 8704);
    for (int it = gw; it < 2048 + 512; it += NGW) {
        if (it < 2048) p0_transpose_item(P.win, DIN, 4096, 1024, Win_t, scr, it, lane);
        else p0_transpose_item(P.wout, 1024, 1024, 1024, Wout_t, scr, it - 2048, lane);
    }
    __syncthreads();
    f32x4 g4[4];
#pragma unroll
    for (int j = 0; j < 4; ++j) g4[j] = *(const f32x4*)(P.gain + 4 * lane + 256 * j);
    const float bfv = P.bfg[lane & 7];
    for (int m = gw; m < MT; m += NGW) {
        const float* xrow = (m < MP) ? P.xp + (size_t)m * 1024 : P.xs + (size_t)(m - MP) * 1024;
        f32x4 v[4]; float ss = 0.f;
#pragma unroll
        for (int j = 0; j < 4; ++j) { v[j] = *(const f32x4*)(xrow + 4 * lane + 256 * j); ss += (v[j][0] * v[j][0] + v[j][1] * v[j][1]) + (v[j][2] * v[j][2] + v[j][3] * v[j][3]); }
        ss = wave_sum(ss);
        const float rstd = 1.0f / sqrtf(ss * (1.0f / 1024.0f) + RMS_EPS);
        float z0 = 0.f, z1 = 0.f, z2 = 0.f, z3 = 0.f, z4 = 0.f, z5 = 0.f, z6 = 0.f, z7 = 0.f;
#pragma unroll
        for (int j = 0; j < 4; ++j) {
            const f32x4 hv = v[j] * rstd * g4[j];
            u32x2 w; w.x = pk2(hv[0], hv[1]); w.y = pk2(hv[2], hv[3]);
            *(u32x2*)(H + (size_t)m * 1024 + 4 * lane + 256 * j) = w;
#pragma unroll
            for (int e = 0; e < 4; ++e) {
                const int k = 4 * lane + 256 * j + e;
                const f32x4 w0 = *(const LAS f32x4*)(wfL + k * 8), w1 = *(const LAS f32x4*)(wfL + k * 8 + 4);
                z0 += hv[e] * w0[0]; z1 += hv[e] * w0[1]; z2 += hv[e] * w0[2]; z3 += hv[e] * w0[3];
                z4 += hv[e] * w1[0]; z5 += hv[e] * w1[1]; z6 += hv[e] * w1[2]; z7 += hv[e] * w1[3];
            }
        }
        z0 = wave_sum(z0); z1 = wave_sum(z1); z2 = wave_sum(z2); z3 = wave_sum(z3); z4 = wave_sum(z4); z5 = wave_sum(z5); z6 = wave_sum(z6); z7 = wave_sum(z7);
        float zs = z0; zs = (lane == 1) ? z1 : zs; zs = (lane == 2) ? z2 : zs; zs = (lane == 3) ? z3 : zs; zs = (lane == 4) ? z4 : zs; zs = (lane == 5) ? z5 : zs; zs = (lane == 6) ? z6 : zs; zs = (lane == 7) ? z7 : zs;
        if (lane < 8) {
            const float t = zs + bfv;
            const float lf = fminf(t, 0.f) - log1pf(expf(-fabsf(t)));
            if (m < MP) P.out[O_LFP + (size_t)m * 8 + lane] = lf; else P.out[O_LFS + (size_t)(m - MP) * 8 + lane] = lf;
        }
    }
    const int gt = blockIdx.x * 512 + tid, NT = G * 512;
    for (int c = gt; c < NSB * LAC * 64; c += NT) { conv_chunk(P.cak, (bf16_t*)(P.ws + WS_KAS), c, 9, LAS_LEN); conv_chunk(P.cav, (bf16_t*)(P.ws + WS_VAS), c, 9, LAS_LEN); }
    for (int c = gt; c < NSB * PAST * 64; c += NT) { conv_chunk(P.cbk, (bf16_t*)(P.ws + WS_KBS), c, 11, LBS_LEN); conv_chunk(P.cbv, (bf16_t*)(P.ws + WS_VBS), c, 11, LBS_LEN); }
}

template <int PER, class LD>
__device__ __forceinline__ void block_cumsum(int n, LD load, float* dst, LAS float* red, int tid) {
    const int lane = tid & 63, w = tid >> 6;
    float v[PER]; float run = 0.f;
#pragma unroll
    for (int e = 0; e < PER; ++e) { const int t = tid * PER + e; const float x = (t < n) ? load(t) : 0.f; run += x; v[e] = run; }
    float inc = run;
#pragma unroll
    for (int o = 1; o < 64; o <<= 1) { const float y = __shfl_up(inc, o); if (lane >= o) inc += y; }
    if (lane == 63) red[w] = inc;
    __syncthreads();
    float off = inc - run;
#pragma unroll
    for (int i = 0; i < 8; ++i) off += (i < w) ? red[i] : 0.f;
#pragma unroll
    for (int e = 0; e < PER; ++e) { const int t = tid * PER + e; if (t < n) dst[t] = (v[e] + off) * LOG2E; }
    __syncthreads();
}

namespace att {
constexpr float THR = 8.0f;
__device__ __forceinline__ int crow(int r, int hi) { return (r & 3) + 8 * (r >> 2) + 4 * hi; }
__device__ __forceinline__ float xhalf_max(float m) {
    auto rr = __builtin_amdgcn_permlane32_swap(__float_as_uint(m), __float_as_uint(m), false, false);
    return fmaxf(__uint_as_float(rr[0]), __uint_as_float(rr[1]));
}
__device__ __forceinline__ float xhalf_sum(float m) {
    auto rr = __builtin_amdgcn_permlane32_swap(__float_as_uint(m), __float_as_uint(m), false, false);
    return __uint_as_float(rr[0]) + __uint_as_float(rr[1]);
}
struct St { float m, l; f32x16 o0, o1; };
__device__ __forceinline__ void st_init(St& S) {
    S.m = 0.f; S.l = 0.f;
#pragma unroll
    for (int r = 0; r < 16; ++r) { S.o0[r] = 0.f; S.o1[r] = 0.f; }
}

template <int MODE>
__device__ __forceinline__ void step(St& S, const bf16x8 (&qf)[4], int kb, int qpos0, bool diag, bool first, float cq, float cfar, const LAS float* tab,
                                     const LAS unsigned char* kimg, unsigned vaddr, int r32, int hi) {
    bf16x8 kf[4];
#pragma unroll
    for (int d0 = 0; d0 < 4; ++d0) kf[d0] = *(const LAS bf16x8*)(kimg + r32 * 128 + (((d0 * 2 + hi) ^ ((r32 >> 1) & 7)) << 4));
    f32x16 s;
    if (MODE == 1) {
        const float nm = cq - S.m;
#pragma unroll
        for (int g = 0; g < 4; ++g) { const f32x4 ck = *(const LAS f32x4*)(tab + kb * 32 + 8 * g + 4 * hi);
#pragma unroll
            for (int e = 0; e < 4; ++e) s[4 * g + e] = nm - ck[e]; }
    } else {
        if (qpos0 - (kb * 32 + 31) >= 128) {
            const float c = cfar - S.m;
#pragma unroll
            for (int r = 0; r < 16; ++r) s[r] = c;
        } else {
            const int dd = qpos0 + r32 - kb * 32 + 128;
#pragma unroll
            for (int r = 0; r < 16; ++r) { int idx = dd - crow(r, hi); idx = idx < 0 ? 0 : (idx > 256 ? 256 : idx); s[r] = tab[idx] - S.m; }
        }
    }
#pragma unroll
    for (int d0 = 0; d0 < 4; ++d0) s = __builtin_amdgcn_mfma_f32_32x32x16_bf16(kf[d0], qf[d0], s, 0, 0, 0);
    if (MODE == 1 && diag) {
#pragma unroll
        for (int r = 0; r < 16; ++r) if (crow(r, hi) > r32) s[r] = -1e30f;
    }
    float rm = fmaxf(fmaxf(s[0], s[1]), fmaxf(s[2], s[3]));
#pragma unroll
    for (int r = 4; r < 16; r += 4) rm = fmaxf(rm, fmaxf(fmaxf(s[r], s[r + 1]), fmaxf(s[r + 2], s[r + 3])));
    rm = xhalf_max(rm);
    if (first || __any(rm > THR)) {
        const float dl = first ? rm : fmaxf(rm, 0.f); S.m += dl;
        const float f = first ? 1.0f : __builtin_amdgcn_exp2f(-dl); S.l *= f;
#pragma unroll
        for (int r = 0; r < 16; ++r) { s[r] -= dl; S.o0[r] *= f; S.o1[r] *= f; }
    }
    float ls = 0.f;
#pragma unroll
    for (int r = 0; r < 16; ++r) { s[r] = __builtin_amdgcn_exp2f(s[r]); ls += s[r]; }
    S.l += ls;
    u32x4 pw0, pw1;
    pw0.x = pk2(s[0], s[1]); pw0.y = pk2(s[2], s[3]); pw0.z = pk2(s[4], s[5]); pw0.w = pk2(s[6], s[7]);
    pw1.x = pk2(s[8], s[9]); pw1.y = pk2(s[10], s[11]); pw1.z = pk2(s[12], s[13]); pw1.w = pk2(s[14], s[15]);
    const bf16x8 pf0 = __builtin_bit_cast(bf16x8, pw0), pf1 = __builtin_bit_cast(bf16x8, pw1);
    s16x4 vlo[4], vhi[4];
#define ATT_TR(dst, off) asm volatile("ds_read_b64_tr_b16 %0, %1 offset:%c2" : "=&v"(dst) : "v"(vaddr), "i"(off) : "memory")
    ATT_TR(vlo[0], 0);    ATT_TR(vhi[0], 1024);
    ATT_TR(vlo[1], 2048); ATT_TR(vhi[1], 3072);
    ATT_TR(vlo[2], 512);  ATT_TR(vhi[2], 1536);
    ATT_TR(vlo[3], 2560); ATT_TR(vhi[3], 3584);
#undef ATT_TR
    asm volatile("s_waitcnt lgkmcnt(0)" ::: "memory");
    __builtin_amdgcn_sched_barrier(0);
#define ATT_VF(i) (bf16x8){vlo[i][0], vlo[i][1], vlo[i][2], vlo[i][3], vhi[i][0], vhi[i][1], vhi[i][2], vhi[i][3]}
    S.o0 = __builtin_amdgcn_mfma_f32_32x32x16_bf16(ATT_VF(0), pf0, S.o0, 0, 0, 0);
    S.o0 = __builtin_amdgcn_mfma_f32_32x32x16_bf16(ATT_VF(1), pf1, S.o0, 0, 0, 0);
    S.o1 = __builtin_amdgcn_mfma_f32_32x32x16_bf16(ATT_VF(2), pf0, S.o1, 0, 0, 0);
    S.o1 = __builtin_amdgcn_mfma_f32_32x32x16_bf16(ATT_VF(3), pf1, S.o1, 0, 0, 0);
#undef ATT_VF
}
__device__ __forceinline__ float max3f(float a, float b, float c) { float r; asm("v_max3_f32 %0, %1, %2, %3" : "=v"(r) : "v"(a), "v"(b), "v"(c)); return r; }
template <int MODE>
__device__ __forceinline__ void step64(St& S, const bf16x8 (&qf)[4], int t, int qpos0, bool diag, bool first, float cq, float cfar, const LAS float* tab,
                                       const LAS unsigned char* buf, unsigned vaddr, int r32, int hi) {
    bf16x8 ka[4], kc[4];
#pragma unroll
    for (int d0 = 0; d0 < 4; ++d0) { const int o = r32 * 128 + (((d0 * 2 + hi) ^ ((r32 >> 1) & 7)) << 4); ka[d0] = *(const LAS bf16x8*)(buf + o); kc[d0] = *(const LAS bf16x8*)(buf + 4096 + o); }
    f32x16 sa, sb;
    if (MODE == 1) {
        const float nm = cq - S.m;
#pragma unroll
        for (int g = 0; g < 4; ++g) { const f32x4 c0 = *(const LAS f32x4*)(tab + t * 64 + 8 * g + 4 * hi), c1 = *(const LAS f32x4*)(tab + t * 64 + 32 + 8 * g + 4 * hi);
#pragma unroll
            for (int e = 0; e < 4; ++e) { sa[4 * g + e] = nm - c0[e]; sb[4 * g + e] = nm - c1[e]; } }
    } else {
        if (qpos0 - (t * 64 + 31) >= 128) {
            const float c = cfar - S.m;
#pragma unroll
            for (int r = 0; r < 16; ++r) sa[r] = c;
        } else {
            const int dd = qpos0 + r32 - t * 64 + 128;
#pragma unroll
            for (int r = 0; r < 16; ++r) { int idx = dd - crow(r, hi); idx = idx < 0 ? 0 : (idx > 256 ? 256 : idx); sa[r] = tab[idx] - S.m; }
        }
        if (qpos0 - (t * 64 + 63) >= 128) {
            const float c = cfar - S.m;
#pragma unroll
            for (int r = 0; r < 16; ++r) sb[r] = c;
        } else {
            const int dd = qpos0 + r32 - t * 64 - 32 + 128;
#pragma unroll
            for (int r = 0; r < 16; ++r) { int idx = dd - crow(r, hi); idx = idx < 0 ? 0 : (idx > 256 ? 256 : idx); sb[r] = tab[idx] - S.m; }
        }
    }
#pragma unroll
    for (int d0 = 0; d0 < 4; ++d0) { sa = __builtin_amdgcn_mfma_f32_32x32x16_bf16(ka[d0], qf[d0], sa, 0, 0, 0); sb = __builtin_amdgcn_mfma_f32_32x32x16_bf16(kc[d0], qf[d0], sb, 0, 0, 0); }
    s16x4 vlo[8], vhi[8];
#define ATT_TR(dst, off) asm volatile("ds_read_b64_tr_b16 %0, %1 offset:%c2" : "=&v"(dst) : "v"(vaddr), "i"(off) : "memory")
    ATT_TR(vlo[0], 0);           ATT_TR(vhi[0], 1024);          ATT_TR(vlo[1], 2048);        ATT_TR(vhi[1], 3072);
    ATT_TR(vlo[2], 512);         ATT_TR(vhi[2], 1536);          ATT_TR(vlo[3], 2560);        ATT_TR(vhi[3], 3584);
    ATT_TR(vlo[4], 4096 + 0);    ATT_TR(vhi[4], 4096 + 1024);   ATT_TR(vlo[5], 4096 + 2048); ATT_TR(vhi[5], 4096 + 3072);
    ATT_TR(vlo[6], 4096 + 512);  ATT_TR(vhi[6], 4096 + 1536);   ATT_TR(vlo[7], 4096 + 2560); ATT_TR(vhi[7], 4096 + 3584);
#undef ATT_TR
    if (MODE == 1 && diag) {
        const int qrel = qpos0 - t * 64 + r32;
#pragma unroll
        for (int r = 0; r < 16; ++r) { if (crow(r, hi) > qrel) sa[r] = -1e30f; if (crow(r, hi) + 32 > qrel) sb[r] = -1e30f; }
    }
    float r0 = max3f(sa[0], sa[1], sa[2]), r1 = max3f(sb[0], sb[1], sb[2]);
#pragma unroll
    for (int r = 3; r < 15; r += 2) { r0 = max3f(r0, sa[r], sa[r + 1]); r1 = max3f(r1, sb[r], sb[r + 1]); }
    float rm = max3f(r0, r1, fmaxf(sa[15], sb[15]));
    rm = xhalf_max(rm);
    if (first || __any(rm > THR)) {
        const float dl = first ? rm : fmaxf(rm, 0.f); S.m += dl;
        const float f = first ? 1.0f : __builtin_amdgcn_exp2f(-dl); S.l *= f;
#pragma unroll
        for (int r = 0; r < 16; ++r) { sa[r] -= dl; sb[r] -= dl; S.o0[r] *= f; S.o1[r] *= f; }
    }
    float l0 = 0.f, l1 = 0.f, l2 = 0.f, l3 = 0.f;
#pragma unroll
    for (int r = 0; r < 16; r += 2) { sa[r] = __builtin_amdgcn_exp2f(sa[r]); sa[r + 1] = __builtin_amdgcn_exp2f(sa[r + 1]); sb[r] = __builtin_amdgcn_exp2f(sb[r]); sb[r + 1] = __builtin_amdgcn_exp2f(sb[r + 1]);
        l0 += sa[r]; l1 += sa[r + 1]; l2 += sb[r]; l3 += sb[r + 1]; }
    S.l += (l0 + l1) + (l2 + l3);
    u32x4 pa0, pa1, pb0, pb1;
    pa0.x = pk2(sa[0], sa[1]); pa0.y = pk2(sa[2], sa[3]); pa0.z = pk2(sa[4], sa[5]); pa0.w = pk2(sa[6], sa[7]);
    pa1.x = pk2(sa[8], sa[9]); pa1.y = pk2(sa[10], sa[11]); pa1.z = pk2(sa[12], sa[13]); pa1.w = pk2(sa[14], sa[15]);
    pb0.x = pk2(sb[0], sb[1]); pb0.y = pk2(sb[2], sb[3]); pb0.z = pk2(sb[4], sb[5]); pb0.w = pk2(sb[6], sb[7]);
    pb1.x = pk2(sb[8], sb[9]); pb1.y = pk2(sb[10], sb[11]); pb1.z = pk2(sb[12], sb[13]); pb1.w = pk2(sb[14], sb[15]);
    asm volatile("s_waitcnt lgkmcnt(0)" ::: "memory");
    __builtin_amdgcn_sched_barrier(0);
#define ATT_VF(i) (bf16x8){vlo[i][0], vlo[i][1], vlo[i][2], vlo[i][3], vhi[i][0], vhi[i][1], vhi[i][2], vhi[i][3]}
#define ATT_PF(x) __builtin_bit_cast(bf16x8, x)
    S.o0 = __builtin_amdgcn_mfma_f32_32x32x16_bf16(ATT_VF(0), ATT_PF(pa0), S.o0, 0, 0, 0);
    S.o1 = __builtin_amdgcn_mfma_f32_32x32x16_bf16(ATT_VF(2), ATT_PF(pa0), S.o1, 0, 0, 0);
    S.o0 = __builtin_amdgcn_mfma_f32_32x32x16_bf16(ATT_VF(1), ATT_PF(pa1), S.o0, 0, 0, 0);
    S.o1 = __builtin_amdgcn_mfma_f32_32x32x16_bf16(ATT_VF(3), ATT_PF(pa1), S.o1, 0, 0, 0);
    S.o0 = __builtin_amdgcn_mfma_f32_32x32x16_bf16(ATT_VF(4), ATT_PF(pb0), S.o0, 0, 0, 0);
    S.o1 = __builtin_amdgcn_mfma_f32_32x32x16_bf16(ATT_VF(6), ATT_PF(pb0), S.o1, 0, 0, 0);
    S.o0 = __builtin_amdgcn_mfma_f32_32x32x16_bf16(ATT_VF(5), ATT_PF(pb1), S.o0, 0, 0, 0);
    S.o1 = __builtin_amdgcn_mfma_f32_32x32x16_bf16(ATT_VF(7), ATT_PF(pb1), S.o1, 0, 0, 0);
#undef ATT_VF
#undef ATT_PF
}
__device__ __forceinline__ unsigned v_lane_off(int lane) { return (unsigned)((4 * (lane >> 5) + ((lane & 15) >> 2)) * 64 + ((lane >> 4) & 1) * 32 + (lane & 3) * 8); }

__device__ __forceinline__ void finish(St& S, bf16_t* Yrow, const bf16_t* __restrict__ Grow, LAS unsigned char* ostage, int lane) {
    const int r32 = lane & 31, hi = lane >> 5;
    const float inv = 1.0f / xhalf_sum(S.l);
#pragma unroll
    for (int db = 0; db < 2; ++db)
#pragma unroll
        for (int g = 0; g < 4; ++g) {
            f32x4 v;
#pragma unroll
            for (int e2 = 0; e2 < 4; ++e2) v[e2] = (db ? S.o1[4 * g + e2] : S.o0[4 * g + e2]) * inv;
            *(LAS f32x4*)(ostage + r32 * 272 + (32 * db + 8 * g + 4 * hi) * 4) = v;
        }
    asm volatile("s_waitcnt lgkmcnt(0)" ::: "memory");
#pragma unroll
    for (int i = 0; i < 4; ++i) {
        const int row = i * 8 + (lane >> 3), c8 = lane & 7;
        const f32x4 a = *(const LAS f32x4*)(ostage + row * 272 + c8 * 32), b = *(const LAS f32x4*)(ostage + row * 272 + c8 * 32 + 16);
        const u32x4 gw = *(const u32x4*)(Grow + row * 64 + c8 * 8);
        u32x4 w;
        w.x = pk2(a[0] * bf_lo(gw.x), a[1] * bf_hi(gw.x)); w.y = pk2(a[2] * bf_lo(gw.y), a[3] * bf_hi(gw.y));
        w.z = pk2(b[0] * bf_lo(gw.z), b[1] * bf_hi(gw.z)); w.w = pk2(b[2] * bf_lo(gw.w), b[3] * bf_hi(gw.w));
        *(u32x4*)(Yrow + (size_t)row * 1024 + c8 * 8) = w;
    }
    asm volatile("s_waitcnt lgkmcnt(0)" ::: "memory");
}

__device__ __forceinline__ void glds16(const void* gsrc, unsigned lds_dst) { unsigned keep;
    asm volatile("s_mov_b32 %0, m0\n\ts_mov_b32 m0, %2\n\ts_nop 0\n\tglobal_load_lds_dwordx4 %1, off\n\ts_mov_b32 m0, %0" : "=&s"(keep) : "v"(gsrc), "s"(lds_dst) : "memory"); }

template <int MODE>
__device__ __forceinline__ void super_unit(const bf16_t* __restrict__ Qrow, const bf16_t* __restrict__ Kb, const bf16_t* __restrict__ Vb, int T0, int T1, int t_lo, int t_hi, int qpos0,
                                           const LAS float* tab, bf16_t* Yrow, const bf16_t* __restrict__ Grow, LAS unsigned char* ring, int tid, int lane) {
    asm volatile("" : "+v"(tid)); lane = tid & 63;
    const int r32 = lane & 31, hi = lane >> 5;
    const int w = __builtin_amdgcn_readfirstlane(tid >> 6);
    bf16x8 qf[4];
#pragma unroll
    for (int d0 = 0; d0 < 4; ++d0) qf[d0] = *(const bf16x8*)(Qrow + r32 * 64 + d0 * 16 + hi * 8);
    const int kkey = 8 * w + (lane >> 3), kch = (lane & 7) ^ ((kkey >> 1) & 7);
    const int vkey = 8 * w + ((lane >> 2) & 7), vch = 4 * ((lane >> 5) & 1) + (lane & 3);
    const bf16_t* kg = Kb + kkey * 64 + kch * 8;
    const bf16_t* vg = Vb + vkey * 64 + vch * 8;
    const unsigned ring0 = (unsigned)(unsigned long)ring;
    const unsigned kdst = (unsigned)__builtin_amdgcn_readfirstlane(ring0 + w * 1024), vdst = kdst + 8192;
    const float cq = (MODE == 1) ? tab[qpos0 + r32] : 0.f;
    const float cfar = (MODE == 0) ? tab[256] : 0.f;
    const unsigned vl = v_lane_off(lane);
    St S; st_init(S);
    asm volatile("" :: "v"(qf[0]), "v"(qf[1]), "v"(qf[2]), "v"(qf[3]));
    int s0 = 0, s1 = 16384, s2 = 32768;
    glds16(kg + (size_t)T0 * 4096, kdst + s0); glds16(vg + (size_t)T0 * 4096, vdst + s0);
    if (T0 + 1 < T1) { glds16(kg + (size_t)(T0 + 1) * 4096, kdst + s1); glds16(vg + (size_t)(T0 + 1) * 4096, vdst + s1);
                       asm volatile("s_waitcnt vmcnt(2) lgkmcnt(0)\n\ts_barrier" ::: "memory"); }
    else             { asm volatile("s_waitcnt vmcnt(0) lgkmcnt(0)\n\ts_barrier" ::: "memory"); }
    for (int t = T0; t < T1; ++t) {
        const bool more = (t + 2 < T1);
        if (more) { glds16(kg + (size_t)(t + 2) * 4096, kdst + s2); glds16(vg + (size_t)(t + 2) * 4096, vdst + s2); }
        LAS unsigned char* buf = ring + s0;
        if (t >= t_lo && t < t_hi)
            step64<MODE>(S, qf, t, qpos0, t == t_hi - 1, t == t_lo, cq, cfar, tab, buf, (unsigned)(unsigned long)(buf + 8192) + vl, r32, hi);
        if (more) asm volatile("s_waitcnt vmcnt(2) lgkmcnt(0)\n\ts_barrier" ::: "memory");
        else      asm volatile("s_waitcnt vmcnt(0) lgkmcnt(0)\n\ts_barrier" ::: "memory");
        const int sn = s0; s0 = s1; s1 = s2; s2 = sn;
    }
    finish(S, Yrow, Grow, ring + 49152 + w * 8704, lane);
}

template <int MODE>
__device__ __forceinline__ void split_unit(const bf16_t* __restrict__ Qrow, const bf16_t* __restrict__ Kb, const bf16_t* __restrict__ Vb, int kb0, int kb1, int kdiag, int qpos0,
                                           const LAS float* tab, bf16_t* Yrow, const bf16_t* __restrict__ Grow, LAS unsigned char* stage0, int wave, int lane) {
    asm volatile("" : "+v"(lane));
    const int r32 = lane & 31, hi = lane >> 5;
    LAS unsigned char* st = stage0 + wave * 8704;
    bf16x8 qf[4];
#pragma unroll
    for (int d0 = 0; d0 < 4; ++d0) qf[d0] = *(const bf16x8*)(Qrow + r32 * 64 + d0 * 16 + hi * 8);
    const int skey = lane >> 3, sch = lane & 7;
    const int kwA = skey * 128 + ((sch ^ (skey >> 1)) << 4), kwB = skey * 128 + ((sch ^ ((skey >> 1) + 4)) << 4);
    const int vw0 = 4096 + (sch >> 2) * 512 + skey * 64 + (sch & 3) * 16;
    const bf16_t* kg = Kb + lane * 8;
    const bf16_t* vg = Vb + lane * 8;
    const unsigned vaddr = (unsigned)(unsigned long)(st + 4096) + v_lane_off(lane);
    u32x4 kr[4], vr[4];
#pragma unroll
    for (int i = 0; i < 4; ++i) { kr[i] = *(const u32x4*)(kg + (size_t)(kb0 * 32 + 8 * i) * 64); vr[i] = *(const u32x4*)(vg + (size_t)(kb0 * 32 + 8 * i) * 64); }
    const float cq = (MODE == 1) ? tab[qpos0 + r32] : 0.f;
    const float cfar = (MODE == 0) ? tab[256] : 0.f;
    St S; st_init(S);
    asm volatile("" :: "v"(qf[0]), "v"(qf[1]), "v"(qf[2]), "v"(qf[3]));
    for (int kb = kb0; kb < kb1; ++kb) {
#pragma unroll
        for (int i = 0; i < 4; ++i) { *(LAS u32x4*)(st + ((i & 1) ? kwB : kwA) + i * 1024) = kr[i]; *(LAS u32x4*)(st + vw0 + i * 1024) = vr[i]; }
        if (kb + 1 < kb1) {
#pragma unroll
            for (int i = 0; i < 4; ++i) { kr[i] = *(const u32x4*)(kg + (size_t)((kb + 1) * 32 + 8 * i) * 64); vr[i] = *(const u32x4*)(vg + (size_t)((kb + 1) * 32 + 8 * i) * 64); }
        }
        step<MODE>(S, qf, kb, qpos0, kb == kdiag, kb == kb0, cq, cfar, tab, st, vaddr, r32, hi);
    }
    LAS float* part = (LAS float*)st;
    const float lt = xhalf_sum(S.l);
    part[0 * 64 + lane] = S.m; part[1 * 64 + lane] = lt;
#pragma unroll
    for (int r = 0; r < 16; ++r) { part[(2 + r) * 64 + lane] = S.o0[r]; part[(18 + r) * 64 + lane] = S.o1[r]; }
    __syncthreads();
    {
        const int db = wave & 1, g = wave >> 1;
        float mw[8]; float M = -3.0e38f;
#pragma unroll
        for (int w = 0; w < 8; ++w) { mw[w] = ((const LAS float*)(stage0 + w * 8704))[lane]; M = fmaxf(M, mw[w]); }
        float L = 0.f, a0 = 0.f, a1 = 0.f, a2 = 0.f, a3 = 0.f;
#pragma unroll
        for (int w = 0; w < 8; ++w) {
            const LAS float* pw = (const LAS float*)(stage0 + w * 8704);
            const float sc = __builtin_amdgcn_exp2f(mw[w] - M);
            L += sc * pw[64 + lane];
            const int base = (2 + 16 * db + 4 * g) * 64 + lane;
            a0 += sc * pw[base]; a1 += sc * pw[base + 64]; a2 += sc * pw[base + 128]; a3 += sc * pw[base + 192];
        }
        const float inv = 1.0f / L;
        const int d = 32 * db + 8 * g + 4 * hi;
        const u32x2 gw2 = *(const u32x2*)(Grow + r32 * 64 + d);
        u32x2 wv; wv.x = pk2(a0 * inv * bf_lo(gw2.x), a1 * inv * bf_hi(gw2.x)); wv.y = pk2(a2 * inv * bf_lo(gw2.y), a3 * inv * bf_hi(gw2.y));
        *(u32x2*)(Yrow + (size_t)r32 * 1024 + d) = wv;
    }
    __syncthreads();
}
}

__device__ __forceinline__ void phase2(const Params& P, LAS unsigned char* lds, int tid, int lane, int wave) {
    LAS float* c2p = (LAS float*)(lds);
    LAS float* c2s = (LAS float*)(lds + 8192);
    LAS float* rb2 = (LAS float*)(lds + 8192 + 8448);
    LAS unsigned char* work = lds + 18432;
    for (int vb = blockIdx.x; vb < 256; vb += gridDim.x) {
        const int b = vb >> 3, h = vb & 7;
        __syncthreads();
        {
            const float* C2P = (const float*)(P.ws + WS_C2P); const float* C2S = (const float*)(P.ws + WS_C2S);
            for (int i = tid; i < 2048; i += 512) c2p[i] = C2P[(size_t)vb * 2048 + i];
            if (vb < 64) for (int i = tid; i < LBS_LEN; i += 512) c2s[i] = C2S[(size_t)vb * LBS_LEN + i];
            for (int i = tid; i < NREL; i += 512) rb2[i] = P.relb[h * NREL + i] * LOG2E;
        }
        __syncthreads();
        if (vb < 128) {
            const int mode = vb < 64, bs = (vb & 63) >> 3;
            const size_t qrow = (size_t)MP + bs * NST;
            const int L = mode ? LBS_LEN : LAS_LEN, nb = L / 32;
            const size_t kvo = (size_t)(bs * 8 + h) * L * 64;
            const size_t qgo = ((size_t)(32 * 8 + h) * 2048 + bs * NST) * 64;
            const int kb0 = (wave * nb) >> 3, kb1 = ((wave + 1) * nb) >> 3;
            const bf16_t* Qrow = (const bf16_t*)(P.ws + WS_SEG + (size_t)(mode ? 4 : 0) * SEG_STRIDE) + qgo;
            const bf16_t* Grow = (const bf16_t*)(P.ws + WS_SEG + (size_t)(mode ? 7 : 3) * SEG_STRIDE) + qgo;
            bf16_t* Yrow = (bf16_t*)(P.ws + WS_H) + qrow * 1024 + (mode ? 512 : 0) + h * 64;
            if (mode) att::split_unit<1>(Qrow, (const bf16_t*)(P.ws + WS_KBS) + kvo, (const bf16_t*)(P.ws + WS_VBS) + kvo, kb0, kb1, nb - 1, PAST, c2s, Yrow, Grow, work, wave, lane);
            else      att::split_unit<0>(Qrow, (const bf16_t*)(P.ws + WS_KAS) + kvo, (const bf16_t*)(P.ws + WS_VAS) + kvo, kb0, kb1, -1, LAC, rb2, Yrow, Grow, work, wave, lane);
        }
        for (int it = 0; it < 16; ++it) {
            const int mode = it < 8, u = it & 7;
            const int hc = 8 * u + wave;
            const size_t qrow = (size_t)b * SEQ + hc * 32;
            const size_t ho = (size_t)(b * 8 + h) * 2048 * 64;
            const bf16_t* Qrow = (const bf16_t*)(P.ws + WS_SEG + (size_t)(mode ? 4 : 0) * SEG_STRIDE) + ho + (size_t)hc * 32 * 64;
            const bf16_t* Grow = (const bf16_t*)(P.ws + WS_SEG + (size_t)(mode ? 7 : 3) * SEG_STRIDE) + ho + (size_t)hc * 32 * 64;
            const bf16_t* Kb = (const bf16_t*)(P.ws + WS_SEG + (size_t)(mode ? 5 : 1) * SEG_STRIDE) + ho;
            const bf16_t* Vb = (const bf16_t*)(P.ws + WS_SEG + (size_t)(mode ? 6 : 2) * SEG_STRIDE) + ho;
            bf16_t* Yrow = (bf16_t*)(P.ws + WS_H) + qrow * 1024 + (mode ? 512 : 0) + h * 64;
            if (mode) {
                att::super_unit<1>(Qrow, Kb, Vb, 0, 4 * u + 4, 0, (hc >> 1) + 1, hc * 32, c2p, Yrow, Grow, work, tid, lane);
            } else {
                const int n = hc >> 1, lo = (n - 8) < 0 ? 0 : (n - 8), t0 = (4 * u - 8) < 0 ? 0 : (4 * u - 8);
                att::super_unit<0>(Qrow, Kb, Vb, t0, 4 * u + 4, lo, n + 1, hc * 32, rb2, Yrow, Grow, work, tid, lane);
            }
        }
    }
}

__device__ __forceinline__ void phase4(const Params& P, int lane, int wave) {
    const int gw = blockIdx.x * 8 + wave, NGW = gridDim.x * 8;
    const bf16_t* mo = (const bf16_t*)(P.ws + WS_SEG);
    f32x4 g4[4];
#pragma unroll
    for (int j = 0; j < 4; ++j) g4[j] = *(const f32x4*)(P.fgain + 4 * lane + 256 * j);
    f32x4 v[4]; u32x2 mv[4];
    int m = gw;
    if (m < MT) {
        const float* xrow = (m < MP) ? P.xp + (size_t)m * 1024 : P.xs + (size_t)(m - MP) * 1024;
#pragma unroll
        for (int j = 0; j < 4; ++j) { v[j] = *(const f32x4*)(xrow + 4 * lane + 256 * j); mv[j] = *(const u32x2*)(mo + (size_t)m * 1024 + 4 * lane + 256 * j); }
    }
    for (; m < MT; m += NGW) {
        f32x4 r[4]; float ss = 0.f;
#pragma unroll
        for (int j = 0; j < 4; ++j) {
            r[j][0] = v[j][0] + bf_lo(mv[j].x); r[j][1] = v[j][1] + bf_hi(mv[j].x); r[j][2] = v[j][2] + bf_lo(mv[j].y); r[j][3] = v[j][3] + bf_hi(mv[j].y);
            ss += (r[j][0] * r[j][0] + r[j][1] * r[j][1]) + (r[j][2] * r[j][2] + r[j][3] * r[j][3]);
        }
        const int mn = m + NGW;
        if (mn < MT) {
            const float* xrow = (mn < MP) ? P.xp + (size_t)mn * 1024 : P.xs + (size_t)(mn - MP) * 1024;
#pragma unroll
            for (int j = 0; j < 4; ++j) { v[j] = *(const f32x4*)(xrow + 4 * lane + 256 * j); mv[j] = *(const u32x2*)(mo + (size_t)mn * 1024 + 4 * lane + 256 * j); }
        }
        ss = wave_sum(ss);
        const float rstd = 1.0f / sqrtf(ss * (1.0f / 1024.0f) + RMS_EPS);
        float* row = P.out + (size_t)m * 1024;
#pragma unroll
        for (int j = 0; j < 4; ++j) *(f32x4*)(row + 4 * lane + 256 * j) = r[j] * rstd * g4[j];
    }
}

#define XB_TMO      128
#define XB_XCNT(j)  (256  + 64 * (j))
#define XB_XSUB(j)  (1280 + 64 * (j))
#define XB_XGEN(j)  (2304 + 64 * (j))
#define XB_TOP      3328
#define XB_TOPGEN   3392
#define XCD_BAR_WORDS 3456
#define XB_SPIN_CAP (1u << 18)

__device__ __forceinline__ unsigned xb_ld(unsigned* p)              { return __hip_atomic_load(p, __ATOMIC_RELAXED, __HIP_MEMORY_SCOPE_AGENT); }
__device__ __forceinline__ unsigned xb_add(unsigned* p, unsigned v) { return __hip_atomic_fetch_add(p, v, __ATOMIC_RELAXED, __HIP_MEMORY_SCOPE_AGENT); }
__device__ __forceinline__ unsigned xb_xcc_id() { return (unsigned)__builtin_amdgcn_s_getreg((3 << 11) | 20) & 0xFu; }
#define XB_SPIN(cond, bar) do { unsigned _sp = 0; while (cond) { __builtin_amdgcn_s_sleep(1); \
    if ((++_sp & 255u) == 0u) { if (xb_ld(&(bar)[XB_TMO])) break; if (_sp > XB_SPIN_CAP) { atomicAdd(&(bar)[XB_TMO], 1u); break; } } } } while (0)

struct XcdBarrier {
    unsigned* bar; unsigned x;
    volatile LAS unsigned* st;
};

__device__ __forceinline__ XcdBarrier xcd_barrier_post(unsigned* bar, volatile LAS unsigned* st) {
    XcdBarrier b; b.bar = bar; b.x = xb_xcc_id(); b.st = st;
    if (threadIdx.x == 0) (void)xb_add(&bar[XB_XCNT(b.x)], 1u);
    return b;
}
__device__ __forceinline__ void xcd_barrier_complete(unsigned* bar, unsigned x, unsigned& nloc, unsigned& nx) {
    const unsigned G = gridDim.x * gridDim.y * gridDim.z;
    unsigned sum, cnt, mine, sp = 0u;
    for (;;) {
        sum = 0u; cnt = 0u; mine = 0u;
#pragma unroll
        for (unsigned j = 0; j < 16; ++j) { const unsigned c = xb_ld(&bar[XB_XCNT(j)]); sum += c; cnt += (c > 0u) ? 1u : 0u; mine = (j == x) ? c : mine; }
        if (sum == G) break;
        __builtin_amdgcn_s_sleep(1);
        if ((++sp & 255u) == 0u) { if (xb_ld(&bar[XB_TMO])) break; if (sp > XB_SPIN_CAP) { atomicAdd(&bar[XB_TMO], 1u); break; } }
    }
    nloc = mine > 0u ? mine : 1u; nx = cnt > 0u ? cnt : 1u;
}

__device__ __forceinline__ void xcd_barrier(const XcdBarrier& b) {
    asm volatile("s_waitcnt vmcnt(0)" ::: "memory");
    __syncthreads();
    if (threadIdx.x == 0) {
        unsigned* bar = b.bar;
        __builtin_amdgcn_s_waitcnt(0);
        unsigned nloc = b.st[0], nx = b.st[1];
        if (nloc == 0u) { xcd_barrier_complete(bar, b.x, nloc, nx); b.st[0] = nloc; b.st[1] = nx; }
        const unsigned old = xb_add(&bar[XB_XSUB(b.x)], 1u);
        const unsigned gen = old / nloc;
        if (old + 1u == (gen + 1u) * nloc) {
            __builtin_amdgcn_fence(__ATOMIC_RELEASE, "agent");
            asm volatile("s_waitcnt vmcnt(0)" ::: "memory");
            const unsigned og = xb_add(&bar[XB_TOP], 1u);
            const unsigned tg = og / nx;
            if (og + 1u == (tg + 1u) * nx) xb_add(&bar[XB_TOPGEN], 1u);
            else XB_SPIN(xb_ld(&bar[XB_TOPGEN]) == tg, bar);
            __builtin_amdgcn_fence(__ATOMIC_ACQUIRE, "agent");
            xb_add(&bar[XB_XGEN(b.x)], 1u);
            asm volatile("s_waitcnt vmcnt(0)" ::: "memory");
        } else {
            XB_SPIN(xb_ld(&bar[XB_XGEN(b.x)]) == gen, bar);
            __builtin_amdgcn_fence(__ATOMIC_ACQUIRE, "agent");
            asm volatile("s_waitcnt vmcnt(0)" ::: "memory");
        }
    }
    __syncthreads();
}

#define LOAD_PARAMS() const Params& P = Parg
__device__ __forceinline__ int my_tid() { int t = (int)threadIdx.x; asm volatile("" : "+v"(t)); return t; }
#define MY_TID() my_tid()
__global__ void __launch_bounds__(512, 2) hymba_fwd(Params Parg) {
    extern __shared__ __attribute__((aligned(16))) unsigned char lds_raw[];
    LAS unsigned char* lds = (LAS unsigned char*)lds_raw;
    cg::grid_group grid = cg::this_grid();
    const int wave = __builtin_amdgcn_readfirstlane((int)threadIdx.x >> 6);
    volatile LAS unsigned* bst = (volatile LAS unsigned*)(lds + LDS_BYTES - 64);
    if (threadIdx.x < 2) bst[threadIdx.x] = 0u;
    __syncthreads();
    const XcdBarrier xbar = xcd_barrier_post((unsigned*)(Parg.ws + WS_BAR), bst);

    {   LOAD_PARAMS(); const int tid = MY_TID();
        phase0(P, lds, tid, tid & 63, wave); }
    if (Parg.ws == nullptr) grid.sync();
    xcd_barrier(xbar);

    {
        LOAD_PARAMS(); const int tid = MY_TID();
        LAS float* red = (LAS float*)(lds);
        for (int u = blockIdx.x; u < 256; u += gridDim.x) {
            const int b = u >> 3, h = u & 7;
            const float* src = P.out + O_LFP + ((size_t)b * SEQ) * 8 + h;
            block_cumsum<4>(SEQ, [&](int t) { return src[(size_t)t * 8]; }, (float*)(P.ws + WS_C2P) + (size_t)u * 2048, red, tid);
        }
        for (int u = blockIdx.x; u < 64; u += gridDim.x) {
            const int b = u >> 3, h = u & 7;
            const float* src0 = P.cblf + ((size_t)b * PAST) * 8 + h;
            const float* src1 = P.out + O_LFS + ((size_t)b * NST) * 8 + h;
            block_cumsum<5>(LBS_LEN, [&](int t) { return t < PAST ? src0[(size_t)t * 8] : src1[(size_t)(t - PAST) * 8]; }, (float*)(P.ws + WS_C2S) + (size_t)u * LBS_LEN, red, tid);
        }
        for (int c = blockIdx.x; c < 256; c += gridDim.x) {
            const int rg = c & 3, cg = c >> 2, seg = cg >> 3, head = cg & 7, kind = seg & 3, grp = seg >> 2;
            const bool kv = (kind == 1 || kind == 2);
            bf16_t* bdst; int L, Pn;
            if (kv) { bdst = (bf16_t*)(P.ws + (grp == 0 ? (kind == 1 ? WS_KAS : WS_VAS) : (kind == 1 ? WS_KBS : WS_VBS))); L = grp == 0 ? LAS_LEN : LBS_LEN; Pn = grp == 0 ? LAC : PAST; }
            else    { bdst = (bf16_t*)(P.ws + WS_SEG + (size_t)seg * SEG_STRIDE); L = 0; Pn = 0; }
            float* fdst = kv ? P.out + (grp == 0 ? (kind == 1 ? O_AKS : O_AVS) : (kind == 1 ? O_BKS : O_BVS)) : nullptr;
            mini_gemm64((const bf16_t*)(P.ws + WS_H) + (size_t)(MP + rg * 64) * 1024, (const bf16_t*)(P.ws + WS_WIN) + (size_t)cg * 64 * 1024, wave, tid & 63,
                [&](int row, int col, f32x4 v) {
                    const int r = rg * 64 + row;
                    if (fdst) *(f32x4*)(fdst + (size_t)r * 512 + head * 64 + col) = v;
                    if (kind == 0) v = v * QSCALE;
                    else if (kind == 3) {
#pragma unroll
                        for (int e = 0; e < 4; ++e) v[e] = v[e] * __builtin_amdgcn_rcpf(1.0f + __builtin_amdgcn_exp2f(-LOG2E * v[e]));
                    }
                    const size_t bidx = kv ? (((size_t)((r >> 5) * 8 + head) * L + Pn + (r & 31)) * 64 + col) : (((size_t)(32 * 8 + head) * 2048 + r) * 64 + col);
                    u32x2 w; w.x = pk2(v[0], v[1]); w.y = pk2(v[2], v[3]);
                    *(u32x2*)(bdst + bidx) = w;
                });
        }
        pg8::Gemm g{(const bf16_t*)(P.ws + WS_H), (const bf16_t*)(P.ws + WS_WIN), MP, 4096, 1024};
        pg8::StaticOrder S; S.init(MP, 4096, (int)gridDim.x, (int)blockIdx.x);
        EpiProj E{P.ws, P.out};
        pg8::gemm_phase<EpiProj, pg8::StaticOrder, true, true>(lds, g, S, E, tid);
    }
    xcd_barrier(xbar);

    {   LOAD_PARAMS(); const int tid = MY_TID();
        phase2(P, lds, tid, tid & 63, wave); }
    xcd_barrier(xbar);

    {
        LOAD_PARAMS(); const int tid = MY_TID();
        for (int c = blockIdx.x; c < 64; c += gridDim.x) {
            const int rg = c & 3, cg = c >> 2;
            bf16_t* mo = (bf16_t*)(P.ws + WS_SEG);
            mini_gemm64((const bf16_t*)(P.ws + WS_H) + (size_t)(MP + rg * 64) * 1024, (const bf16_t*)(P.ws + WS_WOUT) + (size_t)cg * 64 * 1024, wave, tid & 63,
                [&](int row, int col, f32x4 v) {
                    u32x2 w; w.x = pk2(v[0], v[1]); w.y = pk2(v[2], v[3]);
                    *(u32x2*)(mo + (size_t)(MP + rg * 64 + row) * 1024 + cg * 64 + col) = w;
                });
        }
        pg8::Gemm g{(const bf16_t*)(P.ws + WS_H), (const bf16_t*)(P.ws + WS_WOUT), MP, 1024, 1024};
        pg8::StaticOrder S; S.init(MP, 1024, (int)gridDim.x, (int)blockIdx.x);
        EpiOut E{(bf16_t*)(P.ws + WS_SEG)};
        pg8::gemm_phase<EpiOut, pg8::StaticOrder, true, true>(lds, g, S, E, tid);
    }
    xcd_barrier(xbar);

    {   LOAD_PARAMS(); const int tid = MY_TID();
        phase4(P, (int)__builtin_amdgcn_mbcnt_hi(~0u, __builtin_amdgcn_mbcnt_lo(~0u, 0u)), wave); }
}

extern "C" void kernel_launch(void* const* d_in, const int* in_sizes, int n_in, void* d_out, int out_size, void* d_ws, size_t ws_size, hipStream_t stream) {
    static int grid = 0;
    if (grid == 0) {
        if (n_in != 13 || in_sizes[0] != MP * 1024 || (size_t)out_size != O_END || ws_size < WS_END) {
            fprintf(stderr, "kernel_launch: shape mismatch: n_in %d in0 %d out %d (want %zu) ws %zu (want %zu)\n", n_in, n_in > 0 ? in_sizes[0] : -1, out_size, (size_t)O_END, ws_size, (size_t)WS_END);
            grid = -1; return;
        }
        int dev = 0, cus = 0, per_cu = 0;
        hipGetDevice(&dev);
        hipDeviceGetAttribute(&cus, hipDeviceAttributeMultiprocessorCount, dev);
        hipFuncSetAttribute((const void*)hymba_fwd, hipFuncAttributeMaxDynamicSharedMemorySize, LDS_BYTES);
        hipOccupancyMaxActiveBlocksPerMultiprocessor(&per_cu, (const void*)hymba_fwd, 512, LDS_BYTES);
        if (per_cu < 1 || cus < 1) { fprintf(stderr, "kernel_launch: occupancy query gave %d blocks/CU on %d CUs\n", per_cu, cus); grid = -1; return; }
        grid = cus * per_cu;
        if (grid > 256) grid = 256;
    }
    if (grid < 0) return;
    Params p{};
    p.xp = (const float*)d_in[0]; p.xs = (const float*)d_in[1]; p.cak = (const float*)d_in[2]; p.cav = (const float*)d_in[3]; p.cbk = (const float*)d_in[4]; p.cbv = (const float*)d_in[5];
    p.cblf = (const float*)d_in[6]; p.gain = (const float*)d_in[7]; p.win = (const float*)d_in[8]; p.bfg = (const float*)d_in[9]; p.relb = (const float*)d_in[10]; p.wout = (const float*)d_in[11];
    p.fgain = (const float*)d_in[12]; p.out = (float*)d_out; p.ws = (unsigned char*)d_ws;
    if (hipMemsetAsync((unsigned char*)d_ws + WS_BAR, 0, BAR_BYTES, stream) != hipSuccess) { fprintf(stderr, "kernel_launch: memset of the barrier words failed\n"); return; }
    void* args[] = {&p};
    hipError_t e = hipLaunchCooperativeKernel((const void*)hymba_fwd, dim3(grid), dim3(512), args, LDS_BYTES, stream);
    if (e != hipSuccess) fprintf(stderr, "cooperative launch failed: %s (grid %d)\n", hipGetErrorString(e), grid);
}
```

```cpp
#include <hip/hip_runtime.h>
#include <hip/hip_cooperative_groups.h>
#include <cstdio>
#include <cstdint>
namespace cg = cooperative_groups;
namespace pg8 {
#define PG8_LAS __attribute__((address_space(3)))
typedef unsigned short bf16_t;
typedef short bf16x8 __attribute__((ext_vector_type(8)));
typedef float f32x4 __attribute__((ext_vector_type(4)));
typedef unsigned u32x4 __attribute__((ext_vector_type(4)));
constexpr int BM = 256, BK = 64, HALF = 128, HTB = HALF * BK * 2  , STAGE_BYTES = 8 * HTB, NXCD = 8, WGM = 8;

__host__ __device__ __forceinline__ int lds_byte(int r, int c) { const int st = (r >> 4) * 2 + (c >> 5), rr = r & 15, cc = c & 31, ob = rr * 64 + cc * 2; return st * 1024 + (ob ^ (((ob >> 9) & 1) << 5)); }
__host__ __device__ __forceinline__ void stage_rc(int b, int& R, int& C) { const int st = b / 1024, sb = b % 1024, swz = sb ^ (((sb >> 9) & 1) << 5); R = (st >> 1) * 16 + swz / 64; C = (st & 1) * 32 + (swz % 64) / 2; }
__host__ __device__ __forceinline__ int perm32(int rho) { const int n = rho >> 4, i = rho & 15; return 8 * (i >> 2) + 4 * n + (i & 3); }

struct Unit { int pm, pn; };
struct Gemm { const bf16_t* A; const bf16_t* Bt; int M, N, K; };

struct StaticOrder {
    int nM, nN, nwg, G, c;
    __host__ __device__ void init(int M, int N, int G_, int c_) { nM = M / BM; nN = N / BM; nwg = nM * nN; G = G_; c = c_; }
    __host__ __device__ bool next(int i, Unit& u) const {
        const long L = (long)i * G + c; if (L >= nwg) return false;
        int wgid = (int)L; { const int q = nwg / NXCD, r = nwg % NXCD, xcd = wgid % NXCD, off = wgid / NXCD; wgid = (xcd < r ? xcd * (q + 1) : r * (q + 1) + (xcd - r) * q) + off; }
        const int nig = WGM * nN, gid = wgid / nig, fm = gid * WGM, gsz = (nM - fm) < WGM ? (nM - fm) : WGM;
        u.pm = fm + ((wgid % nig) % gsz); u.pn = (wgid % nig) / gsz; return true;
    }
    __device__ __forceinline__ void a_ready(const Unit&) const {}
    __device__ __forceinline__ void done(const Unit&) const {}
};
__device__ __forceinline__ unsigned cvt_pk_bf16(float lo, float hi) { unsigned r; asm volatile("v_cvt_pk_bf16_f32 %0, %1, %2" : "=v"(r) : "v"(lo), "v"(hi)); return r; }
typedef float f32x2 __attribute__((ext_vector_type(2)));
template <class Epi, class Sched, bool ALIGN_EPI = false, bool SP2 = false>
__device__ __forceinline__ void gemm_phase(PG8_LAS unsigned char* lds, const Gemm g, const Sched& S, const Epi& E, const int tid) {
    const int wid = __builtin_amdgcn_readfirstlane(tid >> 6), lane = tid & 63, wr = wid >> 2, wc = wid & 3, fr = lane & 15, fq = lane >> 4;
    const int K = g.K, nt = K / BK;
    unsigned voffA[2], voffB[2];
#pragma unroll
    for (int i = 0; i < 2; ++i) { int R, C; stage_rc(tid * 16 + i * 8192, R, C); const int Rb = Epi::PERM ? ((R & ~31) + perm32(R & 31)) : R;
        voffA[i] = (unsigned)(R * K + C) * 2u; voffB[i] = (unsigned)(Rb * K + C) * 2u; }
    const size_t kstep = (size_t)(BK * 2);
    const size_t hstep = (size_t)HALF * K * 2;
    const size_t tstep = 2 * hstep;
    const unsigned ldsw = (unsigned)wid * 1024u;
    const int aoff = lds_byte(wr * 64 + fr, fq * 8), boff = lds_byte(wc * 32 + fr, fq * 8);
#define PG8_SA(b, h) (((b) * 2 + (h)) * HTB)
#define PG8_SB(b, h) ((4 + (b) * 2 + (h)) * HTB)
#define PG8_STAGE(bufoff, gbase, voff) do { _Pragma("unroll") for (int _i = 0; _i < 2; ++_i) \
        __builtin_amdgcn_global_load_lds((const unsigned*)((const char*)(gbase) + (voff)[_i]), (PG8_LAS unsigned*)(lds + (bufoff) + ldsw + _i * 8192), 16, 0, 0); } while (0)
#define PG8_LDA(dst, b, h) do { _Pragma("unroll") for (int m = 0; m < 4; ++m) _Pragma("unroll") for (int k = 0; k < 2; ++k) dst[m][k] = *(const PG8_LAS bf16x8*)(lds + PG8_SA(b, h) + aoff + m * 2048 + k * 1024); } while (0)
#define PG8_LDB(dst, b, h) do { _Pragma("unroll") for (int n = 0; n < 2; ++n) _Pragma("unroll") for (int k = 0; k < 2; ++k) dst[n][k] = *(const PG8_LAS bf16x8*)(lds + PG8_SB(b, h) + boff + n * 2048 + k * 1024); } while (0)
#define PG8_MMA(ai, bj, At, Bt) do { __builtin_amdgcn_s_setprio(1); _Pragma("unroll") for (int m = 0; m < 4; ++m) _Pragma("unroll") for (int n = 0; n < 2; ++n) _Pragma("unroll") for (int k = 0; k < 2; ++k) \
        acc[ai][bj][m][n] = __builtin_amdgcn_mfma_f32_16x16x32_bf16(Bt[n][k], At[m][k], acc[ai][bj][m][n], 0, 0, 0); __builtin_amdgcn_s_setprio(0); } while (0)
#define PG8_WAIT_V(n) asm volatile("s_waitcnt vmcnt(" #n ")" ::: "memory")
#define PG8_WAIT_L(n) asm volatile("s_waitcnt lgkmcnt(" #n ")" ::: "memory")
#define PG8_BAR __builtin_amdgcn_s_barrier()
#define PG8_SCHED __builtin_amdgcn_sched_barrier(0)
    Unit cur, nxt; int ui = 0;
    if (!S.next(0, cur)) return;
    f32x4 acc[2][2][4][2];
#pragma unroll
    for (int a = 0; a < 2; ++a)
#pragma unroll
        for (int b = 0; b < 2; ++b)
#pragma unroll
            for (int m = 0; m < 4; ++m)
#pragma unroll
                for (int n = 0; n < 2; ++n) acc[a][b][m][n] = (f32x4){0.f, 0.f, 0.f, 0.f};
    bf16x8 At[4][2], B0[2][2], B1[2][2];
    const char* cA = (const char*)g.A + (size_t)cur.pm * tstep; const char* cB = (const char*)g.Bt + (size_t)cur.pn * tstep;
    S.a_ready(cur);
    if constexpr (SP2) {
        PG8_STAGE(PG8_SB(0, 0), cB, voffB); PG8_STAGE(PG8_SB(0, 1), cB + hstep, voffB); PG8_STAGE(PG8_SA(0, 0), cA, voffA); PG8_STAGE(PG8_SA(0, 1), cA + hstep, voffA);
        if (wr == 1) PG8_BAR;
        PG8_WAIT_V(2); PG8_BAR;
        PG8_STAGE(PG8_SB(1, 0), cB + kstep, voffB); PG8_STAGE(PG8_SA(1, 0), cA + kstep, voffA); PG8_STAGE(PG8_SB(1, 1), cB + hstep + kstep, voffB);
        PG8_WAIT_V(6); PG8_BAR;
    } else {
        PG8_STAGE(PG8_SB(0, 0), cB, voffB); PG8_STAGE(PG8_SA(0, 0), cA, voffA); PG8_STAGE(PG8_SB(0, 1), cB + hstep, voffB); PG8_STAGE(PG8_SA(0, 1), cA + hstep, voffA);
        if (wr == 1) PG8_BAR;
        PG8_WAIT_V(4); PG8_BAR;
        PG8_STAGE(PG8_SB(1, 0), cB + kstep, voffB); PG8_STAGE(PG8_SA(1, 0), cA + kstep, voffA); PG8_STAGE(PG8_SB(1, 1), cB + hstep + kstep, voffB);
        PG8_WAIT_V(6); PG8_BAR;
    }
    for (;;) {
        const bool has_next = S.next(ui + 1, nxt);
        const char* nA = has_next ? (const char*)g.A + (size_t)nxt.pm * tstep : cA; const char* nB = has_next ? (const char*)g.Bt + (size_t)nxt.pn * tstep : cB;
        for (int t = 0; t < nt; t += 2) {
            const bool last = (t == nt - 2);
            const char* a1 = cA + (size_t)(t + 1) * kstep;
            const char* a2 = last ? nA : cA + (size_t)(t + 2) * kstep; const char* b2 = last ? nB : cB + (size_t)(t + 2) * kstep;
            const char* a3 = a2 + kstep; const char* b3 = b2 + kstep;
            if (last && has_next) S.a_ready(nxt);
            if constexpr (SP2) {
            PG8_LDB(B0, 0, 0); PG8_LDB(B1, 0, 1); PG8_SCHED; PG8_LDA(At, 0, 0); PG8_STAGE(PG8_SA(1, 1), a1 + hstep, voffA);
            PG8_WAIT_V(8); PG8_WAIT_L(0); PG8_BAR; PG8_MMA(0, 0, At, B0); PG8_MMA(0, 1, At, B1); PG8_BAR; PG8_SCHED;
            PG8_LDA(At, 0, 1); PG8_STAGE(PG8_SB(0, 0), b2, voffB); PG8_STAGE(PG8_SB(0, 1), b2 + hstep, voffB); PG8_STAGE(PG8_SA(0, 0), a2, voffA);
            PG8_WAIT_V(8); PG8_WAIT_L(0); PG8_BAR; PG8_MMA(1, 0, At, B0); PG8_MMA(1, 1, At, B1); PG8_BAR; PG8_SCHED;
            PG8_LDB(B0, 1, 0); PG8_LDB(B1, 1, 1); PG8_SCHED; PG8_LDA(At, 1, 0); PG8_STAGE(PG8_SA(0, 1), a2 + hstep, voffA);
            PG8_WAIT_V(8); PG8_WAIT_L(0); PG8_BAR; PG8_MMA(0, 0, At, B0); PG8_MMA(0, 1, At, B1); PG8_BAR; PG8_SCHED;
            PG8_LDA(At, 1, 1); PG8_STAGE(PG8_SB(1, 0), b3, voffB); PG8_STAGE(PG8_SB(1, 1), b3 + hstep, voffB); PG8_STAGE(PG8_SA(1, 0), a3, voffA);
            PG8_WAIT_V(8); PG8_WAIT_L(0); PG8_BAR; PG8_MMA(1, 0, At, B0); PG8_MMA(1, 1, At, B1); PG8_BAR; PG8_SCHED;
            } else {
            PG8_LDB(B0, 0, 0); PG8_SCHED; PG8_LDA(At, 0, 0); PG8_STAGE(PG8_SA(1, 1), a1 + hstep, voffA);
            PG8_WAIT_L(8); PG8_BAR; PG8_WAIT_L(0); PG8_MMA(0, 0, At, B0); PG8_BAR; PG8_SCHED;
            PG8_LDB(B1, 0, 1); PG8_STAGE(PG8_SB(0, 0), b2, voffB);
            PG8_BAR; PG8_WAIT_L(0); PG8_MMA(0, 1, At, B1); PG8_BAR;
            PG8_LDA(At, 0, 1); PG8_STAGE(PG8_SA(0, 0), a2, voffA);
            PG8_BAR; PG8_WAIT_L(0); PG8_MMA(1, 0, At, B0); PG8_BAR; PG8_SCHED;
            PG8_STAGE(PG8_SB(0, 1), b2 + hstep, voffB);
            PG8_WAIT_V(6); PG8_BAR; PG8_MMA(1, 1, At, B1); PG8_BAR;
            PG8_LDB(B0, 1, 0); PG8_SCHED; PG8_LDA(At, 1, 0); PG8_STAGE(PG8_SA(0, 1), a2 + hstep, voffA);
            PG8_WAIT_L(8); PG8_BAR; PG8_WAIT_L(0); PG8_MMA(0, 0, At, B0); PG8_BAR; PG8_SCHED;
            PG8_LDB(B1, 1, 1); PG8_STAGE(PG8_SB(1, 0), b3, voffB);
            PG8_BAR; PG8_WAIT_L(0); PG8_MMA(0, 1, At, B1); PG8_BAR;
            PG8_LDA(At, 1, 1); PG8_STAGE(PG8_SA(1, 0), a3, voffA);
            PG8_BAR; PG8_WAIT_L(0); PG8_MMA(1, 0, At, B0); PG8_BAR; PG8_SCHED;
            PG8_STAGE(PG8_SB(1, 1), b3 + hstep, voffB);
            PG8_WAIT_V(6); PG8_BAR; PG8_MMA(1, 1, At, B1); PG8_BAR;
            }
        }
        if constexpr (ALIGN_EPI) { if (wr == 0) PG8_BAR; }
        if constexpr (!Epi::AFTER_DRAIN) { E(acc, cur, wr, wc, fr, fq); S.done(cur); }
        if (!has_next) break;
#pragma unroll
        for (int a = 0; a < 2; ++a)
#pragma unroll
            for (int b = 0; b < 2; ++b)
#pragma unroll
                for (int m = 0; m < 4; ++m)
#pragma unroll
                    for (int n = 0; n < 2; ++n) acc[a][b][m][n] = (f32x4){0.f, 0.f, 0.f, 0.f};
        cur = nxt; cA = nA; cB = nB; ++ui;
        if constexpr (ALIGN_EPI) { if (wr == 1) PG8_BAR; }
    }
    PG8_WAIT_V(0);
    if constexpr (!ALIGN_EPI) { if (wr == 0) PG8_BAR; }
    PG8_BAR;
    if constexpr (Epi::AFTER_DRAIN) { E.fused(acc, cur, wr, wc, fr, fq, lds, wid, lane); S.done(cur); }
#undef PG8_SA
#undef PG8_SB
#undef PG8_STAGE
#undef PG8_LDA
#undef PG8_LDB
#undef PG8_MMA
#undef PG8_WAIT_V
#undef PG8_WAIT_L
#undef PG8_BAR
#undef PG8_SCHED
}
}

#define LAS __attribute__((address_space(3)))
typedef unsigned short bf16_t;
typedef short bf16x8 __attribute__((ext_vector_type(8)));
typedef short s16x4 __attribute__((ext_vector_type(4)));
typedef float f32x4 __attribute__((ext_vector_type(4)));
typedef float f32x16 __attribute__((ext_vector_type(16)));
typedef unsigned u32x4 __attribute__((ext_vector_type(4)));
typedef unsigned u32x2 __attribute__((ext_vector_type(2)));

constexpr int DM = 1024, NB = 32, SEQ = 2048, MP = NB * SEQ, NSB = 8, NST = 32, MS = NSB * NST, MT = MP + MS;
constexpr int PAST = 2048, LAC = 512, DIN = 4104, NREL = 257;
constexpr int LAS_LEN = LAC + NST  , LBS_LEN = PAST + NST  ;
constexpr float LOG2E = 1.4426950408889634f, QSCALE = 0.125f * LOG2E, RMS_EPS = 1e-6f;

constexpr size_t O_Y = 0;
constexpr size_t O_AKP = (size_t)MT * 1024;
constexpr size_t O_AVP = O_AKP + (size_t)NB * 512 * 512;
constexpr size_t O_BKP = O_AVP + (size_t)NB * 512 * 512;
constexpr size_t O_BVP = O_BKP + (size_t)MP * 512;
constexpr size_t O_LFP = O_BVP + (size_t)MP * 512;
constexpr size_t O_AKS = O_LFP + (size_t)MP * 8;
constexpr size_t O_AVS = O_AKS + (size_t)MS * 512;
constexpr size_t O_BKS = O_AVS + (size_t)MS * 512;
constexpr size_t O_BVS = O_BKS + (size_t)MS * 512;
constexpr size_t O_LFS = O_BVS + (size_t)MS * 512;
constexpr size_t O_END = O_LFS + (size_t)MS * 8;

constexpr size_t MiB = 1u << 20;
constexpr size_t WS_WIN = 0, WS_WOUT = 8 * MiB, WS_C2P = 10 * MiB, WS_C2S = 12 * MiB, WS_PS = 13 * MiB, WS_BAR = 13 * MiB, BAR_BYTES = 16384;
constexpr size_t WS_KAS = 18 * MiB, WS_VAS = 23 * MiB, WS_KBS = 28 * MiB, WS_VBS = 45 * MiB;
constexpr size_t WS_H = 64 * MiB;
constexpr size_t WS_SEG = 200 * MiB, SEG_STRIDE = 66 * MiB;
constexpr size_t WS_END = WS_SEG + 8 * SEG_STRIDE;
static_assert((size_t)33 * 8 * 2048 * 64 * 2 <= SEG_STRIDE && (size_t)MT * 1024 * 2 <= WS_SEG - WS_H && (size_t)MT * 64 <= WS_KAS - WS_PS, "ws map");
static_assert((size_t)NSB * LAS_LEN * 512 * 2 <= 5 * MiB && (size_t)NSB * LBS_LEN * 512 * 2 <= 17 * MiB, "ws map");

constexpr int LDS_BYTES = 147456;

struct Params {
    const float* xp; const float* xs; const float* cak; const float* cav; const float* cbk; const float* cbv; const float* cblf;
    const float* gain; const float* win; const float* bfg; const float* relb; const float* wout; const float* fgain;
    float* out; unsigned char* ws;
};

__device__ __forceinline__ float wave_sum(float v) {
#pragma unroll
    for (int o = 1; o < 64; o <<= 1) v += __shfl_xor(v, o);
    return v;
}
typedef float f32x2_t __attribute__((ext_vector_type(2))); typedef __bf16 bf16x2_t __attribute__((ext_vector_type(2)));
__device__ __forceinline__ unsigned pk2(float lo, float hi) { f32x2_t v = {lo, hi}; bf16x2_t b = __builtin_convertvector(v, bf16x2_t); return __builtin_bit_cast(unsigned, b); }
__device__ __forceinline__ float bf_lo(unsigned w) { return __uint_as_float(w << 16); }
__device__ __forceinline__ float bf_hi(unsigned w) { return __uint_as_float(w & 0xffff0000u); }

struct EpiProj {
    static constexpr bool PERM = true, AFTER_DRAIN = false;
    unsigned char* ws; float* out;
    __device__ __forceinline__ void operator()(const pg8::f32x4 (&acc)[2][2][4][2], const pg8::Unit& u, int wr, int wc, int fr, int fq) const {
        const int seg = u.pn >> 1, kind = seg & 3, grp = seg >> 2;
        const bool smp = (u.pm == MP / 256);
        const bool kv = (kind == 1 || kind == 2);
        const int colw = (u.pn & 1) * 256 + wc * 32 + 8 * fq;
        bf16_t* bbase = (bf16_t*)(ws + WS_SEG + (size_t)seg * SEG_STRIDE);
        int sL = 0, sP = 0;
        if (smp && kv) {
            if (grp == 0) { bbase = (bf16_t*)(ws + (kind == 1 ? WS_KAS : WS_VAS)); sL = LAS_LEN; sP = LAC; }
            else          { bbase = (bf16_t*)(ws + (kind == 1 ? WS_KBS : WS_VBS)); sL = LBS_LEN; sP = PAST; }
        }
        float* fdst = nullptr; unsigned frow0 = 0;
        if (kv) {
            if (smp) { fdst = out + (grp == 0 ? (kind == 1 ? O_AKS : O_AVS) : (kind == 1 ? O_BKS : O_BVS)); }
            else if (grp == 1) { fdst = out + (kind == 1 ? O_BKP : O_BVP); frow0 = (unsigned)u.pm * 256u; }
            else if ((u.pm & 7) >= 6) { fdst = out + (kind == 1 ? O_AKP : O_AVP); frow0 = (unsigned)(u.pm >> 3) * 512u + (unsigned)((u.pm & 7) - 6) * 256u; }
        }
        const int hd0 = (u.pn & 1) * 4 + (wc >> 1), dcol = (wc & 1) * 32 + 8 * fq;
        const unsigned bat = (unsigned)(u.pm >> 3), t0 = (unsigned)(u.pm & 7) * 256u;
#pragma unroll
        for (int ai = 0; ai < 2; ++ai)
#pragma unroll
            for (int m = 0; m < 4; ++m) {
                const int rt = ai * 128 + wr * 64 + m * 16 + fr;
#pragma unroll
                for (int bj = 0; bj < 2; ++bj) {
                    const unsigned head = (unsigned)(hd0 + 2 * bj);
                    const unsigned bidx = sL ? ((((unsigned)(rt >> 5) * 8u + head) * (unsigned)sL + (unsigned)(sP + (rt & 31))) * 64u + (unsigned)dcol)
                                             : (((bat * 8u + head) * 2048u + t0 + (unsigned)rt) * 64u + (unsigned)dcol);
                    pg8::f32x4 v0 = acc[ai][bj][m][0], v1 = acc[ai][bj][m][1];
                    if (fdst) { float* fp = fdst + ((frow0 + (unsigned)rt) * 512u + (unsigned)(colw + bj * 128)); *(pg8::f32x4*)fp = v0; *(pg8::f32x4*)(fp + 4) = v1; }
                    if (kind == 0) { v0 = v0 * QSCALE; v1 = v1 * QSCALE; }
                    else if (kind == 3) {
#pragma unroll
                        for (int e = 0; e < 4; ++e) {
                            v0[e] = v0[e] * __builtin_amdgcn_rcpf(1.0f + __builtin_amdgcn_exp2f(-LOG2E * v0[e]));
                            v1[e] = v1[e] * __builtin_amdgcn_rcpf(1.0f + __builtin_amdgcn_exp2f(-LOG2E * v1[e]));
                        }
                    }
                    pg8::u32x4 w; w.x = pk2(v0[0], v0[1]); w.y = pk2(v0[2], v0[3]); w.z = pk2(v1[0], v1[1]); w.w = pk2(v1[2], v1[3]);
                    *(pg8::u32x4*)(bbase + bidx) = w;
                }
            }
    }
};

struct EpiOut {
    static constexpr bool PERM = true, AFTER_DRAIN = false;
    bf16_t* mo;
    __device__ __forceinline__ void operator()(const pg8::f32x4 (&acc)[2][2][4][2], const pg8::Unit& u, int wr, int wc, int fr, int fq) const {
        const unsigned c0 = (unsigned)(u.pn * 256 + wc * 32 + 8 * fq);
#pragma unroll
        for (int ai = 0; ai < 2; ++ai)
#pragma unroll
            for (int m = 0; m < 4; ++m) {
                const unsigned grow = (unsigned)u.pm * 256u + (unsigned)(ai * 128 + wr * 64 + m * 16 + fr);
#pragma unroll
                for (int bj = 0; bj < 2; ++bj) {
                    const pg8::f32x4 v0 = acc[ai][bj][m][0], v1 = acc[ai][bj][m][1];
                    pg8::u32x4 w; w.x = pk2(v0[0], v0[1]); w.y = pk2(v0[2], v0[3]); w.z = pk2(v1[0], v1[1]); w.w = pk2(v1[2], v1[3]);
                    *(pg8::u32x4*)(mo + (grow * 1024u + c0 + (unsigned)(bj * 128))) = w;
                }
            }
    }
};

template <class F>
__device__ __forceinline__ void mini_gemm64(const bf16_t* __restrict__ A, const bf16_t* __restrict__ Bt, int wave, int lane, F&& epi) {
    const int fr = lane & 15, fq = lane >> 4;
    const bf16_t* ap = A + (size_t)(16 * (wave >> 1) + fr) * 1024 + 8 * fq;
    const bf16_t* b0 = Bt + (size_t)(32 * (wave & 1) + fr) * 1024 + 8 * fq;
    const bf16_t* b1 = b0 + 16 * 1024;
    f32x4 acc0 = {0.f, 0.f, 0.f, 0.f}, acc1 = {0.f, 0.f, 0.f, 0.f};
#pragma unroll 8
    for (int ks = 0; ks < 32; ++ks) {
        const bf16x8 a = *(const bf16x8*)(ap + ks * 32), x0 = *(const bf16x8*)(b0 + ks * 32), x1 = *(const bf16x8*)(b1 + ks * 32);
        acc0 = __builtin_amdgcn_mfma_f32_16x16x32_bf16(x0, a, acc0, 0, 0, 0);
        acc1 = __builtin_amdgcn_mfma_f32_16x16x32_bf16(x1, a, acc1, 0, 0, 0);
    }
    const int row = 16 * (wave >> 1) + fr, col = 32 * (wave & 1) + 4 * fq;
    epi(row, col, acc0); epi(row, col + 16, acc1);
}

__device__ __forceinline__ void p0_transpose_item(const float* W, int ldw, int ncols, int K, bf16_t* WT, LAS float* scr, int item, int lane) {
    const int nblk = ncols / 32, kb = item / nblk, nb = item % nblk, k0 = 64 * kb, n0 = 32 * nb;
#pragma unroll 8
    for (int i = 0; i < 32; ++i) { const int kk = 2 * i + (lane >> 5); scr[kk * 33 + (lane & 31)] = W[(size_t)(k0 + kk) * ldw + n0 + (lane & 31)]; }
    asm volatile("s_waitcnt lgkmcnt(0)" ::: "memory");
    const int c = lane & 7;
#pragma unroll
    for (int j = 0; j < 4; ++j) { const int n = (lane >> 3) + 8 * j; const LAS float* s = scr + (8 * c) * 33 + n;
        u32x4 o; o.x = pk2(s[0 * 33], s[1 * 33]); o.y = pk2(s[2 * 33], s[3 * 33]); o.z = pk2(s[4 * 33], s[5 * 33]); o.w = pk2(s[6 * 33], s[7 * 33]);
        *(u32x4*)(WT + (size_t)(n0 + n) * K + k0 + 8 * c) = o; }
    asm volatile("s_waitcnt lgkmcnt(0)" ::: "memory");
}

__device__ __forceinline__ void conv_chunk(const float* src, bf16_t* dst, int c, int pshift, int L) {
    const int row = c >> 6, col8 = c & 63, b = row >> pshift, pos = row & ((1 << pshift) - 1);
    const f32x4 a = *(const f32x4*)(src + (size_t)c * 8), d = *(const f32x4*)(src + (size_t)c * 8 + 4);
    u32x4 o; o.x = pk2(a[0], a[1]); o.y = pk2(a[2], a[3]); o.z = pk2(d[0], d[1]); o.w = pk2(d[2], d[3]);
    *(u32x4*)(dst + (((size_t)(b * 8 + (col8 >> 3)) * L + pos) * 64 + (col8 & 7) * 8)) = o;
}

__device__ __forceinline__ void phase0(const Params& P, LAS unsigned char* lds, int tid, int lane, int wave) {
    const int G = gridDim.x, gw = blockIdx.x * 8 + wave, NGW = G * 8;
    bf16_t* Win_t = (bf16_t*)(P.ws + WS_WIN); bf16_t* Wout_t = (bf16_t*)(P.ws + WS_WOUT); bf16_t* H = (bf16_t*)(P.ws + WS_H);
    LAS float* wfL = (LAS float*)(lds + 69632);
    for (int i = tid; i < 1024 * 8; i += 512) wfL[i] = P.win[(size_t)(i >> 3) * DIN + 4096 + (i & 7)];
    LAS float* scr = (LAS float*)(lds + wave * 8704);
    for (int it = gw; it < 2048 + 512; it += NGW) {
        if (it < 2048) p0_transpose_item(P.win, DIN, 4096, 1024, Win_t, scr, it, lane);
        else p0_transpose_item(P.wout, 1024, 1024, 1024, Wout_t, scr, it - 2048, lane);
    }
    __syncthreads();
    f32x4 g4[4];
#pragma unroll
    for (int j = 0; j < 4; ++j) g4[j] = *(const f32x4*)(P.gain + 4 * lane + 256 * j);
    const float bfv = P.bfg[lane & 7];
    f32x4 nv[4];
    if (gw < MT) {
        const float* xrow = (gw < MP) ? P.xp + (size_t)gw * 1024 : P.xs + (size_t)(gw - MP) * 1024;
#pragma unroll
        for (int j = 0; j < 4; ++j) nv[j] = *(const f32x4*)(xrow + 4 * lane + 256 * j);
    }
    for (int m = gw; m < MT; m += NGW) {
        f32x4 v[4]; float ss = 0.f;
#pragma unroll
        for (int j = 0; j < 4; ++j) { v[j] = nv[j]; ss += (v[j][0] * v[j][0] + v[j][1] * v[j][1]) + (v[j][2] * v[j][2] + v[j][3] * v[j][3]); }
        if (m + NGW < MT) {
            const int mn = m + NGW;
            const float* xrow = (mn < MP) ? P.xp + (size_t)mn * 1024 : P.xs + (size_t)(mn - MP) * 1024;
#pragma unroll
            for (int j = 0; j < 4; ++j) nv[j] = *(const f32x4*)(xrow + 4 * lane + 256 * j);
        }
        ss = wave_sum(ss);
        const float rstd = 1.0f / sqrtf(ss * (1.0f / 1024.0f) + RMS_EPS);
        float z0 = 0.f, z1 = 0.f, z2 = 0.f, z3 = 0.f, z4 = 0.f, z5 = 0.f, z6 = 0.f, z7 = 0.f;
#pragma unroll
        for (int j = 0; j < 4; ++j) {
            const f32x4 hv = v[j] * rstd * g4[j];
            u32x2 w; w.x = pk2(hv[0], hv[1]); w.y = pk2(hv[2], hv[3]);
            *(u32x2*)(H + (size_t)m * 1024 + 4 * lane + 256 * j) = w;
#pragma unroll
            for (int e = 0; e < 4; ++e) {
                const int k = 4 * lane + 256 * j + e;
                const f32x4 w0 = *(const LAS f32x4*)(wfL + k * 8), w1 = *(const LAS f32x4*)(wfL + k * 8 + 4);
                z0 += hv[e] * w0[0]; z1 += hv[e] * w0[1]; z2 += hv[e] * w0[2]; z3 += hv[e] * w0[3];
                z4 += hv[e] * w1[0]; z5 += hv[e] * w1[1]; z6 += hv[e] * w1[2]; z7 += hv[e] * w1[3];
            }
        }
        z0 = wave_sum(z0); z1 = wave_sum(z1); z2 = wave_sum(z2); z3 = wave_sum(z3); z4 = wave_sum(z4); z5 = wave_sum(z5); z6 = wave_sum(z6); z7 = wave_sum(z7);
        float zs = z0; zs = (lane == 1) ? z1 : zs; zs = (lane == 2) ? z2 : zs; zs = (lane == 3) ? z3 : zs; zs = (lane == 4) ? z4 : zs; zs = (lane == 5) ? z5 : zs; zs = (lane == 6) ? z6 : zs; zs = (lane == 7) ? z7 : zs;
        if (lane < 8) {
            const float t = zs + bfv;
            const float lf = fminf(t, 0.f) - log1pf(expf(-fabsf(t)));
            if (m < MP) P.out[O_LFP + (size_t)m * 8 + lane] = lf; else P.out[O_LFS + (size_t)(m - MP) * 8 + lane] = lf;
        }
    }
    const int gt = blockIdx.x * 512 + tid, NT = G * 512;
    for (int c = gt; c < NSB * LAC * 64; c += NT) { conv_chunk(P.cak, (bf16_t*)(P.ws + WS_KAS), c, 9, LAS_LEN); conv_chunk(P.cav, (bf16_t*)(P.ws + WS_VAS), c, 9, LAS_LEN); }
    for (int c = gt; c < NSB * PAST * 64; c += NT) { conv_chunk(P.cbk, (bf16_t*)(P.ws + WS_KBS), c, 11, LBS_LEN); conv_chunk(P.cbv, (bf16_t*)(P.ws + WS_VBS), c, 11, LBS_LEN); }
}

template <int PER, class LD>
__device__ __forceinline__ void block_cumsum(int n, LD load, float* dst, LAS float* red, int tid) {
    const int lane = tid & 63, w = tid >> 6;
    float v[PER]; float run = 0.f;
#pragma unroll
    for (int e = 0; e < PER; ++e) { const int t = tid * PER + e; const float x = (t < n) ? load(t) : 0.f; run += x; v[e] = run; }
    float inc = run;
#pragma unroll
    for (int o = 1; o < 64; o <<= 1) { const float y = __shfl_up(inc, o); if (lane >= o) inc += y; }
    if (lane == 63) red[w] = inc;
    __syncthreads();
    float off = inc - run;
#pragma unroll
    for (int i = 0; i < 8; ++i) off += (i < w) ? red[i] : 0.f;
#pragma unroll
    for (int e = 0; e < PER; ++e) { const int t = tid * PER + e; if (t < n) dst[t] = (v[e] + off) * LOG2E; }
    __syncthreads();
}

namespace att {
constexpr float THR = 8.0f;
__device__ __forceinline__ int crow(int r, int hi) { return (r & 3) + 8 * (r >> 2) + 4 * hi; }
__device__ __forceinline__ float xhalf_max(float m) {
    auto rr = __builtin_amdgcn_permlane32_swap(__float_as_uint(m), __float_as_uint(m), false, false);
    return fmaxf(__uint_as_float(rr[0]), __uint_as_float(rr[1]));
}
__device__ __forceinline__ float xhalf_sum(float m) {
    auto rr = __builtin_amdgcn_permlane32_swap(__float_as_uint(m), __float_as_uint(m), false, false);
    return __uint_as_float(rr[0]) + __uint_as_float(rr[1]);
}
struct St { float m, l; f32x16 o0, o1; };
__device__ __forceinline__ void st_init(St& S) {
    S.m = 0.f; S.l = 0.f;
#pragma unroll
    for (int r = 0; r < 16; ++r) { S.o0[r] = 0.f; S.o1[r] = 0.f; }
}

template <int MODE>
__device__ __forceinline__ void step(St& S, const bf16x8 (&qf)[4], int kb, int qpos0, bool diag, bool first, float cq, float cfar, const LAS float* tab,
                                     const LAS unsigned char* kimg, unsigned vaddr, int r32, int hi) {
    bf16x8 kf[4];
#pragma unroll
    for (int d0 = 0; d0 < 4; ++d0) kf[d0] = *(const LAS bf16x8*)(kimg + r32 * 128 + (((d0 * 2 + hi) ^ ((r32 >> 1) & 7)) << 4));
    f32x16 s;
    if (MODE == 1) {
        const float nm = cq - S.m;
#pragma unroll
        for (int g = 0; g < 4; ++g) { const f32x4 ck = *(const LAS f32x4*)(tab + kb * 32 + 8 * g + 4 * hi);
#pragma unroll
            for (int e = 0; e < 4; ++e) s[4 * g + e] = nm - ck[e]; }
    } else {
        if (qpos0 - (kb * 32 + 31) >= 128) {
            const float c = cfar - S.m;
#pragma unroll
            for (int r = 0; r < 16; ++r) s[r] = c;
        } else {
            const int dd = qpos0 + r32 - kb * 32 + 128;
#pragma unroll
            for (int r = 0; r < 16; ++r) { int idx = dd - crow(r, hi); idx = idx < 0 ? 0 : (idx > 256 ? 256 : idx); s[r] = tab[idx] - S.m; }
        }
    }
#pragma unroll
    for (int d0 = 0; d0 < 4; ++d0) s = __builtin_amdgcn_mfma_f32_32x32x16_bf16(kf[d0], qf[d0], s, 0, 0, 0);
    if (MODE == 1 && diag) {
#pragma unroll
        for (int r = 0; r < 16; ++r) if (crow(r, hi) > r32) s[r] = -1e30f;
    }
    float rm = fmaxf(fmaxf(s[0], s[1]), fmaxf(s[2], s[3]));
#pragma unroll
    for (int r = 4; r < 16; r += 4) rm = fmaxf(rm, fmaxf(fmaxf(s[r], s[r + 1]), fmaxf(s[r + 2], s[r + 3])));
    rm = xhalf_max(rm);
    if (first || __any(rm > THR)) {
        const float dl = first ? rm : fmaxf(rm, 0.f); S.m += dl;
        const float f = first ? 1.0f : __builtin_amdgcn_exp2f(-dl); S.l *= f;
#pragma unroll
        for (int r = 0; r < 16; ++r) { s[r] -= dl; S.o0[r] *= f; S.o1[r] *= f; }
    }
    float ls = 0.f;
#pragma unroll
    for (int r = 0; r < 16; ++r) { s[r] = __builtin_amdgcn_exp2f(s[r]); ls += s[r]; }
    S.l += ls;
    u32x4 pw0, pw1;
    pw0.x = pk2(s[0], s[1]); pw0.y = pk2(s[2], s[3]); pw0.z = pk2(s[4], s[5]); pw0.w = pk2(s[6], s[7]);
    pw1.x = pk2(s[8], s[9]); pw1.y = pk2(s[10], s[11]); pw1.z = pk2(s[12], s[13]); pw1.w = pk2(s[14], s[15]);
    const bf16x8 pf0 = __builtin_bit_cast(bf16x8, pw0), pf1 = __builtin_bit_cast(bf16x8, pw1);
    s16x4 vlo[4], vhi[4];
#define ATT_TR(dst, off) asm volatile("ds_read_b64_tr_b16 %0, %1 offset:%c2" : "=&v"(dst) : "v"(vaddr), "i"(off) : "memory")
    ATT_TR(vlo[0], 0);    ATT_TR(vhi[0], 1024);
    ATT_TR(vlo[1], 2048); ATT_TR(vhi[1], 3072);
    ATT_TR(vlo[2], 512);  ATT_TR(vhi[2], 1536);
    ATT_TR(vlo[3], 2560); ATT_TR(vhi[3], 3584);
#undef ATT_TR
    asm volatile("s_waitcnt lgkmcnt(0)" ::: "memory");
    __builtin_amdgcn_sched_barrier(0);
#define ATT_VF(i) (bf16x8){vlo[i][0], vlo[i][1], vlo[i][2], vlo[i][3], vhi[i][0], vhi[i][1], vhi[i][2], vhi[i][3]}
    S.o0 = __builtin_amdgcn_mfma_f32_32x32x16_bf16(ATT_VF(0), pf0, S.o0, 0, 0, 0);
    S.o0 = __builtin_amdgcn_mfma_f32_32x32x16_bf16(ATT_VF(1), pf1, S.o0, 0, 0, 0);
    S.o1 = __builtin_amdgcn_mfma_f32_32x32x16_bf16(ATT_VF(2), pf0, S.o1, 0, 0, 0);
    S.o1 = __builtin_amdgcn_mfma_f32_32x32x16_bf16(ATT_VF(3), pf1, S.o1, 0, 0, 0);
#undef ATT_VF
}
__device__ __forceinline__ float max3f(float a, float b, float c) { float r; asm("v_max3_f32 %0, %1, %2, %3" : "=v"(r) : "v"(a), "v"(b), "v"(c)); return r; }
template <int MODE>
__device__ __forceinline__ void step64(St& S, const bf16x8 (&qf)[4], int t, int qpos0, bool diag, bool first, float cq, float cfar, const LAS float* tab,
                                       const LAS unsigned char* buf, unsigned vaddr, int r32, int hi) {
    bf16x8 ka[4], kc[4];
#pragma unroll
    for (int d0 = 0; d0 < 4; ++d0) { const int o = r32 * 128 + (((d0 * 2 + hi) ^ ((r32 >> 1) & 7)) << 4); ka[d0] = *(const LAS bf16x8*)(buf + o); kc[d0] = *(const LAS bf16x8*)(buf + 4096 + o); }
    f32x16 sa, sb;
    if (MODE == 1) {
        const float nm = cq - S.m;
#pragma unroll
        for (int g = 0; g < 4; ++g) { const f32x4 c0 = *(const LAS f32x4*)(tab + t * 64 + 8 * g + 4 * hi), c1 = *(const LAS f32x4*)(tab + t * 64 + 32 + 8 * g + 4 * hi);
#pragma unroll
            for (int e = 0; e < 4; ++e) { sa[4 * g + e] = nm - c0[e]; sb[4 * g + e] = nm - c1[e]; } }
    } else {
        if (qpos0 - (t * 64 + 31) >= 128) {
            const float c = cfar - S.m;
#pragma unroll
            for (int r = 0; r < 16; ++r) sa[r] = c;
        } else {
            const int dd = qpos0 + r32 - t * 64 + 128;
#pragma unroll
            for (int r = 0; r < 16; ++r) { int idx = dd - crow(r, hi); idx = idx < 0 ? 0 : (idx > 256 ? 256 : idx); sa[r] = tab[idx] - S.m; }
        }
        if (qpos0 - (t * 64 + 63) >= 128) {
            const float c = cfar - S.m;
#pragma unroll
            for (int r = 0; r < 16; ++r) sb[r] = c;
        } else {
            const int dd = qpos0 + r32 - t * 64 - 32 + 128;
#pragma unroll
            for (int r = 0; r < 16; ++r) { int idx = dd - crow(r, hi); idx = idx < 0 ? 0 : (idx > 256 ? 256 : idx); sb[r] = tab[idx] - S.m; }
        }
    }
#pragma unroll
    for (int d0 = 0; d0 < 4; ++d0) { sa = __builtin_amdgcn_mfma_f32_32x32x16_bf16(ka[d0], qf[d0], sa, 0, 0, 0); sb = __builtin_amdgcn_mfma_f32_32x32x16_bf16(kc[d0], qf[d0], sb, 0, 0, 0); }
    s16x4 vlo[8], vhi[8];
#define ATT_TR(dst, off) asm volatile("ds_read_b64_tr_b16 %0, %1 offset:%c2" : "=&v"(dst) : "v"(vaddr), "i"(off) : "memory")
    ATT_TR(vlo[0], 0);           ATT_TR(vhi[0], 1024);          ATT_TR(vlo[1], 2048);        ATT_TR(vhi[1], 3072);
    ATT_TR(vlo[2], 512);         ATT_TR(vhi[2], 1536);          ATT_TR(vlo[3], 2560);        ATT_TR(vhi[3], 3584);
    ATT_TR(vlo[4], 4096 + 0);    ATT_TR(vhi[4], 4096 + 1024);   ATT_TR(vlo[5], 4096 + 2048); ATT_TR(vhi[5], 4096 + 3072);
    ATT_TR(vlo[6], 4096 + 512);  ATT_TR(vhi[6], 4096 + 1536);   ATT_TR(vlo[7], 4096 + 2560); ATT_TR(vhi[7], 4096 + 3584);
#undef ATT_TR
    if (MODE == 1 && diag) {
        const int qrel = qpos0 - t * 64 + r32;
#pragma unroll
        for (int r = 0; r < 16; ++r) { if (crow(r, hi) > qrel) sa[r] = -1e30f; if (crow(r, hi) + 32 > qrel) sb[r] = -1e30f; }
    }
    float r0 = max3f(sa[0], sa[1], sa[2]), r1 = max3f(sb[0], sb[1], sb[2]);
#pragma unroll
    for (int r = 3; r < 15; r += 2) { r0 = max3f(r0, sa[r], sa[r + 1]); r1 = max3f(r1, sb[r], sb[r + 1]); }
    float rm = max3f(r0, r1, fmaxf(sa[15], sb[15]));
    rm = xhalf_max(rm);
    if (first || __any(rm > THR)) {
        const float dl = first ? rm : fmaxf(rm, 0.f); S.m += dl;
        const float f = first ? 1.0f : __builtin_amdgcn_exp2f(-dl); S.l *= f;
#pragma unroll
        for (int r = 0; r < 16; ++r) { sa[r] -= dl; sb[r] -= dl; S.o0[r] *= f; S.o1[r] *= f; }
    }
#pragma unroll
    for (int r = 0; r < 16; ++r) { sa[r] = __builtin_amdgcn_exp2f(sa[r]); sb[r] = __builtin_amdgcn_exp2f(sb[r]); }
    asm volatile("s_waitcnt lgkmcnt(0)" ::: "memory");
    __builtin_amdgcn_sched_barrier(0);
    u32x4 pa0, pa1, pb0, pb1;
    pa0.x = pk2(sa[0], sa[1]); pa0.y = pk2(sa[2], sa[3]); pa0.z = pk2(sa[4], sa[5]); pa0.w = pk2(sa[6], sa[7]);
    pa1.x = pk2(sa[8], sa[9]); pa1.y = pk2(sa[10], sa[11]); pa1.z = pk2(sa[12], sa[13]); pa1.w = pk2(sa[14], sa[15]);
    pb0.x = pk2(sb[0], sb[1]); pb0.y = pk2(sb[2], sb[3]); pb0.z = pk2(sb[4], sb[5]); pb0.w = pk2(sb[6], sb[7]);
    pb1.x = pk2(sb[8], sb[9]); pb1.y = pk2(sb[10], sb[11]); pb1.z = pk2(sb[12], sb[13]); pb1.w = pk2(sb[14], sb[15]);
#define ATT_VF(i) (bf16x8){vlo[i][0], vlo[i][1], vlo[i][2], vlo[i][3], vhi[i][0], vhi[i][1], vhi[i][2], vhi[i][3]}
#define ATT_PF(x) __builtin_bit_cast(bf16x8, x)
    S.o0 = __builtin_amdgcn_mfma_f32_32x32x16_bf16(ATT_VF(0), ATT_PF(pa0), S.o0, 0, 0, 0);
    S.o1 = __builtin_amdgcn_mfma_f32_32x32x16_bf16(ATT_VF(2), ATT_PF(pa0), S.o1, 0, 0, 0);
    S.o0 = __builtin_amdgcn_mfma_f32_32x32x16_bf16(ATT_VF(1), ATT_PF(pa1), S.o0, 0, 0, 0);
    S.o1 = __builtin_amdgcn_mfma_f32_32x32x16_bf16(ATT_VF(3), ATT_PF(pa1), S.o1, 0, 0, 0);
    S.o0 = __builtin_amdgcn_mfma_f32_32x32x16_bf16(ATT_VF(4), ATT_PF(pb0), S.o0, 0, 0, 0);
    S.o1 = __builtin_amdgcn_mfma_f32_32x32x16_bf16(ATT_VF(6), ATT_PF(pb0), S.o1, 0, 0, 0);
    S.o0 = __builtin_amdgcn_mfma_f32_32x32x16_bf16(ATT_VF(5), ATT_PF(pb1), S.o0, 0, 0, 0);
    S.o1 = __builtin_amdgcn_mfma_f32_32x32x16_bf16(ATT_VF(7), ATT_PF(pb1), S.o1, 0, 0, 0);
#undef ATT_VF
#undef ATT_PF
    float l0 = 0.f, l1 = 0.f, l2 = 0.f, l3 = 0.f;
#pragma unroll
    for (int r = 0; r < 16; r += 2) { l0 += sa[r]; l1 += sa[r + 1]; l2 += sb[r]; l3 += sb[r + 1]; }
    S.l += (l0 + l1) + (l2 + l3);
    __builtin_amdgcn_sched_group_barrier(0x002, 4, 0);
#pragma unroll
    for (int i = 0; i < 8; ++i) { __builtin_amdgcn_sched_group_barrier(0x008, 1, 0); __builtin_amdgcn_sched_group_barrier(0x002, 6, 0); }
}
__device__ __forceinline__ unsigned v_lane_off(int lane) { return (unsigned)((4 * (lane >> 5) + ((lane & 15) >> 2)) * 64 + ((lane >> 4) & 1) * 32 + (lane & 3) * 8); }

__device__ __forceinline__ void finish(St& S, bf16_t* Yrow, const bf16_t* __restrict__ Grow, LAS unsigned char* ostage, int lane) {
    const int r32 = lane & 31, hi = lane >> 5;
    const float inv = 1.0f / xhalf_sum(S.l);
#pragma unroll
    for (int db = 0; db < 2; ++db)
#pragma unroll
        for (int g = 0; g < 4; ++g) {
            f32x4 v;
#pragma unroll
            for (int e2 = 0; e2 < 4; ++e2) v[e2] = (db ? S.o1[4 * g + e2] : S.o0[4 * g + e2]) * inv;
            *(LAS f32x4*)(ostage + r32 * 272 + (32 * db + 8 * g + 4 * hi) * 4) = v;
        }
    asm volatile("s_waitcnt lgkmcnt(0)" ::: "memory");
#pragma unroll
    for (int i = 0; i < 4; ++i) {
        const int row = i * 8 + (lane >> 3), c8 = lane & 7;
        const f32x4 a = *(const LAS f32x4*)(ostage + row * 272 + c8 * 32), b = *(const LAS f32x4*)(ostage + row * 272 + c8 * 32 + 16);
        const u32x4 gw = *(const u32x4*)(Grow + row * 64 + c8 * 8);
        u32x4 w;
        w.x = pk2(a[0] * bf_lo(gw.x), a[1] * bf_hi(gw.x)); w.y = pk2(a[2] * bf_lo(gw.y), a[3] * bf_hi(gw.y));
        w.z = pk2(b[0] * bf_lo(gw.z), b[1] * bf_hi(gw.z)); w.w = pk2(b[2] * bf_lo(gw.w), b[3] * bf_hi(gw.w));
        *(u32x4*)(Yrow + (size_t)row * 1024 + c8 * 8) = w;
    }
    asm volatile("s_waitcnt lgkmcnt(0)" ::: "memory");
}

__device__ __forceinline__ void glds16(const void* gsrc, unsigned lds_dst) { unsigned keep;
    asm volatile("s_mov_b32 %0, m0\n\ts_mov_b32 m0, %2\n\ts_nop 0\n\tglobal_load_lds_dwordx4 %1, off\n\ts_mov_b32 m0, %0" : "=&s"(keep) : "v"(gsrc), "s"(lds_dst) : "memory"); }

template <int MODE>
__device__ __forceinline__ void super_unit(const bf16_t* __restrict__ Qrow, const bf16_t* __restrict__ Kb, const bf16_t* __restrict__ Vb, int T0, int T1, int t_lo, int t_hi, int qpos0,
                                           const LAS float* tab, bf16_t* Yrow, const bf16_t* __restrict__ Grow, LAS unsigned char* ring, int tid, int lane) {
    asm volatile("" : "+v"(tid)); lane = tid & 63;
    const int r32 = lane & 31, hi = lane >> 5;
    const int w = __builtin_amdgcn_readfirstlane(tid >> 6);
    bf16x8 qf[4];
#pragma unroll
    for (int d0 = 0; d0 < 4; ++d0) qf[d0] = *(const bf16x8*)(Qrow + r32 * 64 + d0 * 16 + hi * 8);
    const int kkey = 8 * w + (lane >> 3), kch = (lane & 7) ^ ((kkey >> 1) & 7);
    const int vkey = 8 * w + ((lane >> 2) & 7), vch = 4 * ((lane >> 5) & 1) + (lane & 3);
    const bf16_t* kg = Kb + kkey * 64 + kch * 8;
    const bf16_t* vg = Vb + vkey * 64 + vch * 8;
    const unsigned ring0 = (unsigned)(unsigned long)ring;
    const unsigned kdst = (unsigned)__builtin_amdgcn_readfirstlane(ring0 + w * 1024), vdst = kdst + 8192;
    const float cq = (MODE == 1) ? tab[qpos0 + r32] : 0.f;
    const float cfar = (MODE == 0) ? tab[256] : 0.f;
    const unsigned vl = v_lane_off(lane);
    St S; st_init(S);
    asm volatile("" :: "v"(qf[0]), "v"(qf[1]), "v"(qf[2]), "v"(qf[3]));
    constexpr bool REV = (MODE == 1);
#define SU_T(s) (REV ? (T0 + T1 - 1 - (s)) : (s))
    int s0 = 0, s1 = 16384, s2 = 32768;
    glds16(kg + (size_t)SU_T(T0) * 4096, kdst + s0); glds16(vg + (size_t)SU_T(T0) * 4096, vdst + s0);
    if (T0 + 1 < T1) { glds16(kg + (size_t)SU_T(T0 + 1) * 4096, kdst + s1); glds16(vg + (size_t)SU_T(T0 + 1) * 4096, vdst + s1);
                       asm volatile("s_waitcnt vmcnt(2) lgkmcnt(0)\n\ts_barrier" ::: "memory"); }
    else             { asm volatile("s_waitcnt vmcnt(0) lgkmcnt(0)\n\ts_barrier" ::: "memory"); }
    for (int s = T0; s < T1; ++s) {
        const int t = SU_T(s);
        const bool more = (s + 2 < T1);
        if (more) { glds16(kg + (size_t)SU_T(s + 2) * 4096, kdst + s2); glds16(vg + (size_t)SU_T(s + 2) * 4096, vdst + s2); }
        LAS unsigned char* buf = ring + s0;
        if (t >= t_lo && t < t_hi)
            step64<MODE>(S, qf, t, qpos0, t == t_hi - 1, REV ? (t == t_hi - 1) : (t == t_lo), cq, cfar, tab, buf, (unsigned)(unsigned long)(buf + 8192) + vl, r32, hi);
        if (more) asm volatile("s_waitcnt vmcnt(2) lgkmcnt(0)\n\ts_barrier" ::: "memory");
        else      asm volatile("s_waitcnt vmcnt(0) lgkmcnt(0)\n\ts_barrier" ::: "memory");
        const int sn = s0; s0 = s1; s1 = s2; s2 = sn;
    }
#undef SU_T
    finish(S, Yrow, Grow, ring + 49152 + w * 8704, lane);
}

template <int MODE>
__device__ __forceinline__ void split_unit(const bf16_t* __restrict__ Qrow, const bf16_t* __restrict__ Kb, const bf16_t* __restrict__ Vb, int kb0, int kb1, int kdiag, int qpos0,
                                           const LAS float* tab, bf16_t* Yrow, const bf16_t* __restrict__ Grow, LAS unsigned char* stage0, int wave, int lane) {
    asm volatile("" : "+v"(lane));
    const int r32 = lane & 31, hi = lane >> 5;
    LAS unsigned char* st = stage0 + wave * 8704;
    bf16x8 qf[4];
#pragma unroll
    for (int d0 = 0; d0 < 4; ++d0) qf[d0] = *(const bf16x8*)(Qrow + r32 * 64 + d0 * 16 + hi * 8);
    const int skey = lane >> 3, sch = lane & 7;
    const int kwA = skey * 128 + ((sch ^ (skey >> 1)) << 4), kwB = skey * 128 + ((sch ^ ((skey >> 1) + 4)) << 4);
    const int vw0 = 4096 + (sch >> 2) * 512 + skey * 64 + (sch & 3) * 16;
    const bf16_t* kg = Kb + lane * 8;
    const bf16_t* vg = Vb + lane * 8;
    const unsigned vaddr = (unsigned)(unsigned long)(st + 4096) + v_lane_off(lane);
    u32x4 kr[4], vr[4];
#pragma unroll
    for (int i = 0; i < 4; ++i) { kr[i] = *(const u32x4*)(kg + (size_t)(kb0 * 32 + 8 * i) * 64); vr[i] = *(const u32x4*)(vg + (size_t)(kb0 * 32 + 8 * i) * 64); }
    const float cq = (MODE == 1) ? tab[qpos0 + r32] : 0.f;
    const float cfar = (MODE == 0) ? tab[256] : 0.f;
    St S; st_init(S);
    asm volatile("" :: "v"(qf[0]), "v"(qf[1]), "v"(qf[2]), "v"(qf[3]));
    for (int kb = kb0; kb < kb1; ++kb) {
#pragma unroll
        for (int i = 0; i < 4; ++i) { *(LAS u32x4*)(st + ((i & 1) ? kwB : kwA) + i * 1024) = kr[i]; *(LAS u32x4*)(st + vw0 + i * 1024) = vr[i]; }
        if (kb + 1 < kb1) {
#pragma unroll
            for (int i = 0; i < 4; ++i) { kr[i] = *(const u32x4*)(kg + (size_t)((kb + 1) * 32 + 8 * i) * 64); vr[i] = *(const u32x4*)(vg + (size_t)((kb + 1) * 32 + 8 * i) * 64); }
        }
        step<MODE>(S, qf, kb, qpos0, kb == kdiag, kb == kb0, cq, cfar, tab, st, vaddr, r32, hi);
    }
    LAS float* part = (LAS float*)st;
    const float lt = xhalf_sum(S.l);
    part[0 * 64 + lane] = S.m; part[1 * 64 + lane] = lt;
#pragma unroll
    for (int r = 0; r < 16; ++r) { part[(2 + r) * 64 + lane] = S.o0[r]; part[(18 + r) * 64 + lane] = S.o1[r]; }
    __syncthreads();
    {
        const int db = wave & 1, g = wave >> 1;
        float mw[8]; float M = -3.0e38f;
#pragma unroll
        for (int w = 0; w < 8; ++w) { mw[w] = ((const LAS float*)(stage0 + w * 8704))[lane]; M = fmaxf(M, mw[w]); }
        float L = 0.f, a0 = 0.f, a1 = 0.f, a2 = 0.f, a3 = 0.f;
#pragma unroll
        for (int w = 0; w < 8; ++w) {
            const LAS float* pw = (const LAS float*)(stage0 + w * 8704);
            const float sc = __builtin_amdgcn_exp2f(mw[w] - M);
            L += sc * pw[64 + lane];
            const int base = (2 + 16 * db + 4 * g) * 64 + lane;
            a0 += sc * pw[base]; a1 += sc * pw[base + 64]; a2 += sc * pw[base + 128]; a3 += sc * pw[base + 192];
        }
        const float inv = 1.0f / L;
        const int d = 32 * db + 8 * g + 4 * hi;
        const u32x2 gw2 = *(const u32x2*)(Grow + r32 * 64 + d);
        u32x2 wv; wv.x = pk2(a0 * inv * bf_lo(gw2.x), a1 * inv * bf_hi(gw2.x)); wv.y = pk2(a2 * inv * bf_lo(gw2.y), a3 * inv * bf_hi(gw2.y));
        *(u32x2*)(Yrow + (size_t)r32 * 1024 + d) = wv;
    }
    __syncthreads();
}
}

__device__ __forceinline__ void phase2(const Params& P, LAS unsigned char* lds, int tid, int lane, int wave) {
    LAS float* c2p = (LAS float*)(lds);
    LAS float* c2s = (LAS float*)(lds + 8192);
    LAS float* rb2 = (LAS float*)(lds + 8192 + 8448);
    LAS unsigned char* work = lds + 18432;
    for (int vb = blockIdx.x; vb < 256; vb += gridDim.x) {
        const int b = vb >> 3, h = vb & 7;
        __syncthreads();
        {
            const float* C2P = (const float*)(P.ws + WS_C2P); const float* C2S = (const float*)(P.ws + WS_C2S);
            for (int i = tid; i < 2048; i += 512) c2p[i] = C2P[(size_t)vb * 2048 + i];
            if (vb < 64) for (int i = tid; i < LBS_LEN; i += 512) c2s[i] = C2S[(size_t)vb * LBS_LEN + i];
            for (int i = tid; i < NREL; i += 512) rb2[i] = P.relb[h * NREL + i] * LOG2E;
        }
        __syncthreads();
        if (vb < 128) {
            const int mode = vb < 64, bs = (vb & 63) >> 3;
            const size_t qrow = (size_t)MP + bs * NST;
            const int L = mode ? LBS_LEN : LAS_LEN, nb = L / 32;
            const size_t kvo = (size_t)(bs * 8 + h) * L * 64;
            const size_t qgo = ((size_t)(32 * 8 + h) * 2048 + bs * NST) * 64;
            const int kb0 = (wave * nb) >> 3, kb1 = ((wave + 1) * nb) >> 3;
            const bf16_t* Qrow = (const bf16_t*)(P.ws + WS_SEG + (size_t)(mode ? 4 : 0) * SEG_STRIDE) + qgo;
            const bf16_t* Grow = (const bf16_t*)(P.ws + WS_SEG + (size_t)(mode ? 7 : 3) * SEG_STRIDE) + qgo;
            bf16_t* Yrow = (bf16_t*)(P.ws + WS_H) + qrow * 1024 + (mode ? 512 : 0) + h * 64;
            if (mode) att::split_unit<1>(Qrow, (const bf16_t*)(P.ws + WS_KBS) + kvo, (const bf16_t*)(P.ws + WS_VBS) + kvo, kb0, kb1, nb - 1, PAST, c2s, Yrow, Grow, work, wave, lane);
            else      att::split_unit<0>(Qrow, (const bf16_t*)(P.ws + WS_KAS) + kvo, (const bf16_t*)(P.ws + WS_VAS) + kvo, kb0, kb1, -1, LAC, rb2, Yrow, Grow, work, wave, lane);
        }
        for (int it = 0; it < 16; ++it) {
            const int mode = it < 8, u = it & 7;
            const int hc = 8 * u + wave;
            const size_t qrow = (size_t)b * SEQ + hc * 32;
            const size_t ho = (size_t)(b * 8 + h) * 2048 * 64;
            const bf16_t* Qrow = (const bf16_t*)(P.ws + WS_SEG + (size_t)(mode ? 4 : 0) * SEG_STRIDE) + ho + (size_t)hc * 32 * 64;
            const bf16_t* Grow = (const bf16_t*)(P.ws + WS_SEG + (size_t)(mode ? 7 : 3) * SEG_STRIDE) + ho + (size_t)hc * 32 * 64;
            const bf16_t* Kb = (const bf16_t*)(P.ws + WS_SEG + (size_t)(mode ? 5 : 1) * SEG_STRIDE) + ho;
            const bf16_t* Vb = (const bf16_t*)(P.ws + WS_SEG + (size_t)(mode ? 6 : 2) * SEG_STRIDE) + ho;
            bf16_t* Yrow = (bf16_t*)(P.ws + WS_H) + qrow * 1024 + (mode ? 512 : 0) + h * 64;
            if (mode) {
                att::super_unit<1>(Qrow, Kb, Vb, 0, 4 * u + 4, 0, (hc >> 1) + 1, hc * 32, c2p, Yrow, Grow, work, tid, lane);
            } else {
                const int n = hc >> 1, lo = (n - 8) < 0 ? 0 : (n - 8), t0 = (4 * u - 8) < 0 ? 0 : (4 * u - 8);
                att::super_unit<0>(Qrow, Kb, Vb, t0, 4 * u + 4, lo, n + 1, hc * 32, rb2, Yrow, Grow, work, tid, lane);
            }
        }
    }
}

__device__ __forceinline__ void phase4(const Params& P, int lane, int wave) {
    const int gw = blockIdx.x * 8 + wave, NGW = gridDim.x * 8;
    const bf16_t* mo = (const bf16_t*)(P.ws + WS_SEG);
    f32x4 g4[4];
#pragma unroll
    for (int j = 0; j < 4; ++j) g4[j] = *(const f32x4*)(P.fgain + 4 * lane + 256 * j);
    f32x4 v[4]; u32x2 mv[4];
    int m = gw;
    if (m < MT) {
        const float* xrow = (m < MP) ? P.xp + (size_t)m * 1024 : P.xs + (size_t)(m - MP) * 1024;
#pragma unroll
        for (int j = 0; j < 4; ++j) { v[j] = *(const f32x4*)(xrow + 4 * lane + 256 * j); mv[j] = *(const u32x2*)(mo + (size_t)m * 1024 + 4 * lane + 256 * j); }
    }
    for (; m < MT; m += NGW) {
        f32x4 r[4]; float ss = 0.f;
#pragma unroll
        for (int j = 0; j < 4; ++j) {
            r[j][0] = v[j][0] + bf_lo(mv[j].x); r[j][1] = v[j][1] + bf_hi(mv[j].x); r[j][2] = v[j][2] + bf_lo(mv[j].y); r[j][3] = v[j][3] + bf_hi(mv[j].y);
            ss += (r[j][0] * r[j][0] + r[j][1] * r[j][1]) + (r[j][2] * r[j][2] + r[j][3] * r[j][3]);
        }
        const int mn = m + NGW;
        if (mn < MT) {
            const float* xrow = (mn < MP) ? P.xp + (size_t)mn * 1024 : P.xs + (size_t)(mn - MP) * 1024;
#pragma unroll
            for (int j = 0; j < 4; ++j) { v[j] = *(const f32x4*)(xrow + 4 * lane + 256 * j); mv[j] = *(const u32x2*)(mo + (size_t)mn * 1024 + 4 * lane + 256 * j); }
        }
        ss = wave_sum(ss);
        const float rstd = 1.0f / sqrtf(ss * (1.0f / 1024.0f) + RMS_EPS);
        float* row = P.out + (size_t)m * 1024;
#pragma unroll
        for (int j = 0; j < 4; ++j) *(f32x4*)(row + 4 * lane + 256 * j) = r[j] * rstd * g4[j];
    }
}

#define XB_TMO      128
#define XB_XCNT(j)  (256  + 64 * (j))
#define XB_XSUB(j)  (1280 + 64 * (j))
#define XB_XGEN(j)  (2304 + 64 * (j))
#define XB_TOP      3328
#define XB_TOPGEN   3392
#define XCD_BAR_WORDS 3456
#define XB_SPIN_CAP (1u << 18)

__device__ __forceinline__ unsigned xb_ld(unsigned* p)              { return __hip_atomic_load(p, __ATOMIC_RELAXED, __HIP_MEMORY_SCOPE_AGENT); }
__device__ __forceinline__ unsigned xb_add(unsigned* p, unsigned v) { return __hip_atomic_fetch_add(p, v, __ATOMIC_RELAXED, __HIP_MEMORY_SCOPE_AGENT); }
__device__ __forceinline__ unsigned xb_xcc_id() { return (unsigned)__builtin_amdgcn_s_getreg((3 << 11) | 20) & 0xFu; }
#define XB_SPIN(cond, bar) do { unsigned _sp = 0; while (cond) { __builtin_amdgcn_s_sleep(1); \
    if ((++_sp & 255u) == 0u) { if (xb_ld(&(bar)[XB_TMO])) break; if (_sp > XB_SPIN_CAP) { atomicAdd(&(bar)[XB_TMO], 1u); break; } } } } while (0)

struct XcdBarrier {
    unsigned* bar; unsigned x;
    volatile LAS unsigned* st;
};

__device__ __forceinline__ XcdBarrier xcd_barrier_post(unsigned* bar, volatile LAS unsigned* st) {
    XcdBarrier b; b.bar = bar; b.x = xb_xcc_id(); b.st = st;
    if (threadIdx.x == 0) (void)xb_add(&bar[XB_XCNT(b.x)], 1u);
    return b;
}
__device__ __forceinline__ void xcd_barrier_complete(unsigned* bar, unsigned x, unsigned& nloc, unsigned& nx) {
    const unsigned G = gridDim.x * gridDim.y * gridDim.z;
    unsigned sum, cnt, mine, sp = 0u;
    for (;;) {
        sum = 0u; cnt = 0u; mine = 0u;
#pragma unroll
        for (unsigned j = 0; j < 16; ++j) { const unsigned c = xb_ld(&bar[XB_XCNT(j)]); sum += c; cnt += (c > 0u) ? 1u : 0u; mine = (j == x) ? c : mine; }
        if (sum == G) break;
        __builtin_amdgcn_s_sleep(1);
        if ((++sp & 255u) == 0u) { if (xb_ld(&bar[XB_TMO])) break; if (sp > XB_SPIN_CAP) { atomicAdd(&bar[XB_TMO], 1u); break; } }
    }
    nloc = mine > 0u ? mine : 1u; nx = cnt > 0u ? cnt : 1u;
}

__device__ __forceinline__ void xcd_barrier(const XcdBarrier& b) {
    asm volatile("s_waitcnt vmcnt(0)" ::: "memory");
    __syncthreads();
    if (threadIdx.x == 0) {
        unsigned* bar = b.bar;
        __builtin_amdgcn_s_waitcnt(0);
        unsigned nloc = b.st[0], nx = b.st[1];
        if (nloc == 0u) { xcd_barrier_complete(bar, b.x, nloc, nx); b.st[0] = nloc; b.st[1] = nx; }
        const unsigned old = xb_add(&bar[XB_XSUB(b.x)], 1u);
        const unsigned gen = old / nloc;
        if (old + 1u == (gen + 1u) * nloc) {
            __builtin_amdgcn_fence(__ATOMIC_RELEASE, "agent");
            asm volatile("s_waitcnt vmcnt(0)" ::: "memory");
            const unsigned og = xb_add(&bar[XB_TOP], 1u);
            const unsigned tg = og / nx;
            if (og + 1u == (tg + 1u) * nx) xb_add(&bar[XB_TOPGEN], 1u);
            else XB_SPIN(xb_ld(&bar[XB_TOPGEN]) == tg, bar);
            __builtin_amdgcn_fence(__ATOMIC_ACQUIRE, "agent");
            xb_add(&bar[XB_XGEN(b.x)], 1u);
            asm volatile("s_waitcnt vmcnt(0)" ::: "memory");
        } else {
            XB_SPIN(xb_ld(&bar[XB_XGEN(b.x)]) == gen, bar);
            __builtin_amdgcn_fence(__ATOMIC_ACQUIRE, "agent");
            asm volatile("s_waitcnt vmcnt(0)" ::: "memory");
        }
    }
    __syncthreads();
}

#define LOAD_PARAMS() const Params& P = Parg
__device__ __forceinline__ int my_tid() { int t = (int)threadIdx.x; asm volatile("" : "+v"(t)); return t; }
#define MY_TID() my_tid()
__global__ void __launch_bounds__(512, 2) hymba_fwd(Params Parg) {
    extern __shared__ __attribute__((aligned(16))) unsigned char lds_raw[];
    LAS unsigned char* lds = (LAS unsigned char*)lds_raw;
    cg::grid_group grid = cg::this_grid();
    const int wave = __builtin_amdgcn_readfirstlane((int)threadIdx.x >> 6);
    volatile LAS unsigned* bst = (volatile LAS unsigned*)(lds + LDS_BYTES - 64);
    if (threadIdx.x < 2) bst[threadIdx.x] = 0u;
    __syncthreads();
    const XcdBarrier xbar = xcd_barrier_post((unsigned*)(Parg.ws + WS_BAR), bst);

    {   LOAD_PARAMS(); const int tid = MY_TID();
        phase0(P, lds, tid, tid & 63, wave); }
    if (Parg.ws == nullptr) grid.sync();
    xcd_barrier(xbar);

    {
        LOAD_PARAMS(); const int tid = MY_TID();
        LAS float* red = (LAS float*)(lds);
        for (int u = blockIdx.x; u < 256; u += gridDim.x) {
            const int b = u >> 3, h = u & 7;
            const float* src = P.out + O_LFP + ((size_t)b * SEQ) * 8 + h;
            block_cumsum<4>(SEQ, [&](int t) { return src[(size_t)t * 8]; }, (float*)(P.ws + WS_C2P) + (size_t)u * 2048, red, tid);
        }
        for (int u = blockIdx.x; u < 64; u += gridDim.x) {
            const int b = u >> 3, h = u & 7;
            const float* src0 = P.cblf + ((size_t)b * PAST) * 8 + h;
            const float* src1 = P.out + O_LFS + ((size_t)b * NST) * 8 + h;
            block_cumsum<5>(LBS_LEN, [&](int t) { return t < PAST ? src0[(size_t)t * 8] : src1[(size_t)(t - PAST) * 8]; }, (float*)(P.ws + WS_C2S) + (size_t)u * LBS_LEN, red, tid);
        }
        for (int c = blockIdx.x; c < 256; c += gridDim.x) {
            const int rg = c & 3, cg = c >> 2, seg = cg >> 3, head = cg & 7, kind = seg & 3, grp = seg >> 2;
            const bool kv = (kind == 1 || kind == 2);
            bf16_t* bdst; int L, Pn;
            if (kv) { bdst = (bf16_t*)(P.ws + (grp == 0 ? (kind == 1 ? WS_KAS : WS_VAS) : (kind == 1 ? WS_KBS : WS_VBS))); L = grp == 0 ? LAS_LEN : LBS_LEN; Pn = grp == 0 ? LAC : PAST; }
            else    { bdst = (bf16_t*)(P.ws + WS_SEG + (size_t)seg * SEG_STRIDE); L = 0; Pn = 0; }
            float* fdst = kv ? P.out + (grp == 0 ? (kind == 1 ? O_AKS : O_AVS) : (kind == 1 ? O_BKS : O_BVS)) : nullptr;
            mini_gemm64((const bf16_t*)(P.ws + WS_H) + (size_t)(MP + rg * 64) * 1024, (const bf16_t*)(P.ws + WS_WIN) + (size_t)cg * 64 * 1024, wave, tid & 63,
                [&](int row, int col, f32x4 v) {
                    const int r = rg * 64 + row;
                    if (fdst) *(f32x4*)(fdst + (size_t)r * 512 + head * 64 + col) = v;
                    if (kind == 0) v = v * QSCALE;
                    else if (kind == 3) {
#pragma unroll
                        for (int e = 0; e < 4; ++e) v[e] = v[e] * __builtin_amdgcn_rcpf(1.0f + __builtin_amdgcn_exp2f(-LOG2E * v[e]));
                    }
                    const size_t bidx = kv ? (((size_t)((r >> 5) * 8 + head) * L + Pn + (r & 31)) * 64 + col) : (((size_t)(32 * 8 + head) * 2048 + r) * 64 + col);
                    u32x2 w; w.x = pk2(v[0], v[1]); w.y = pk2(v[2], v[3]);
                    *(u32x2*)(bdst + bidx) = w;
                });
        }
        pg8::Gemm g{(const bf16_t*)(P.ws + WS_H), (const bf16_t*)(P.ws + WS_WIN), MP, 4096, 1024};
        pg8::StaticOrder S; S.init(MP, 4096, (int)gridDim.x, (int)blockIdx.x);
        EpiProj E{P.ws, P.out};
        pg8::gemm_phase<EpiProj, pg8::StaticOrder, true, true>(lds, g, S, E, tid);
    }
    xcd_barrier(xbar);

    {   LOAD_PARAMS(); const int tid = MY_TID();
        phase2(P, lds, tid, tid & 63, wave); }
    xcd_barrier(xbar);

    {
        LOAD_PARAMS(); const int tid = MY_TID();
        for (int c = blockIdx.x; c < 64; c += gridDim.x) {
            const int rg = c & 3, cg = c >> 2;
            bf16_t* mo = (bf16_t*)(P.ws + WS_SEG);
            mini_gemm64((const bf16_t*)(P.ws + WS_H) + (size_t)(MP + rg * 64) * 1024, (const bf16_t*)(P.ws + WS_WOUT) + (size_t)cg * 64 * 1024, wave, tid & 63,
                [&](int row, int col, f32x4 v) {
                    u32x2 w; w.x = pk2(v[0], v[1]); w.y = pk2(v[2], v[3]);
                    *(u32x2*)(mo + (size_t)(MP + rg * 64 + row) * 1024 + cg * 64 + col) = w;
                });
        }
        pg8::Gemm g{(const bf16_t*)(P.ws + WS_H), (const bf16_t*)(P.ws + WS_WOUT), MP, 1024, 1024};
        pg8::StaticOrder S; S.init(MP, 1024, (int)gridDim.x, (int)blockIdx.x);
        EpiOut E{(bf16_t*)(P.ws + WS_SEG)};
        pg8::gemm_phase<EpiOut, pg8::StaticOrder, true, true>(lds, g, S, E, tid);
    }
    xcd_barrier(xbar);

    {   LOAD_PARAMS(); const int tid = MY_TID();
        phase4(P, (int)__builtin_amdgcn_mbcnt_hi(~0u, __builtin_amdgcn_mbcnt_lo(~0u, 0u)), wave); }
}

extern "C" void kernel_launch(void* const* d_in, const int* in_sizes, int n_in, void* d_out, int out_size, void* d_ws, size_t ws_size, hipStream_t stream) {
    static int grid = 0;
    if (grid == 0) {
        if (n_in != 13 || in_sizes[0] != MP * 1024 || (size_t)out_size != O_END || ws_size < WS_END) {
            fprintf(stderr, "kernel_launch: shape mismatch: n_in %d in0 %d out %d (want %zu) ws %zu (want %zu)\n", n_in, n_in > 0 ? in_sizes[0] : -1, out_size, (size_t)O_END, ws_size, (size_t)WS_END);
            grid = -1; return;
        }
        int dev = 0, cus = 0, per_cu = 0;
        hipGetDevice(&dev);
        hipDeviceGetAttribute(&cus, hipDeviceAttributeMultiprocessorCount, dev);
        hipFuncSetAttribute((const void*)hymba_fwd, hipFuncAttributeMaxDynamicSharedMemorySize, LDS_BYTES);
        hipOccupancyMaxActiveBlocksPerMultiprocessor(&per_cu, (const void*)hymba_fwd, 512, LDS_BYTES);
        if (per_cu < 1 || cus < 1) { fprintf(stderr, "kernel_launch: occupancy query gave %d blocks/CU on %d CUs\n", per_cu, cus); grid = -1; return; }
        grid = cus * per_cu;
        if (grid > 256) grid = 256;
    }
    if (grid < 0) return;
    Params p{};
    p.xp = (const float*)d_in[0]; p.xs = (const float*)d_in[1]; p.cak = (const float*)d_in[2]; p.cav = (const float*)d_in[3]; p.cbk = (const float*)d_in[4]; p.cbv = (const float*)d_in[5];
    p.cblf = (const float*)d_in[6]; p.gain = (const float*)d_in[7]; p.win = (const float*)d_in[8]; p.bfg = (const float*)d_in[9]; p.relb = (const float*)d_in[10]; p.wout = (const float*)d_in[11];
    p.fgain = (const float*)d_in[12]; p.out = (float*)d_out; p.ws = (unsigned char*)d_ws;
    if (hipMemsetAsync((unsigned char*)d_ws + WS_BAR, 0, BAR_BYTES, stream) != hipSuccess) { fprintf(stderr, "kernel_launch: memset of the barrier words failed\n"); return; }
    void* args[] = {&p};
    hipError_t e = hipLaunchCooperativeKernel((const void*)hymba_fwd, dim3(grid), dim3(512), args, LDS_BYTES, stream);
    if (e != hipSuccess) fprintf(stderr, "cooperative launch failed: %s (grid %d)\n", hipGetErrorString(e), grid);
}
```
